# Optimizing an MI355X kernel written in HIP

```python
import math
import jax, jax.numpy as jnp
from jax import lax
import numpy as np

D_MODEL = 1024
BATCH = 8
SEQ = 4096
DEPTH = 4

N_A_LAYERS = DEPTH // 2
N_B_LAYERS = DEPTH - N_A_LAYERS
SSM_GROUP = 16
N_GROUPS = D_MODEL // SSM_GROUP
SSM_STATE = 64
DT_MIN = 1e-3
DT_MAX = 1e-1
N_HEADS = 16
HEAD_DIM = D_MODEL // N_HEADS
Q_BLOCK = 128
ATTN_SCALE = HEAD_DIM ** -0.5
D_FF = ((8 * D_MODEL // 3 + 127) // 128) * 128
CONV_W = 3
EPS = 1e-6

kernel_name = "yoco_s5_fox_convffn_trunk"


def rmsnorm(x, g):
    xf = x.astype(jnp.float32)
    y = xf * lax.rsqrt(jnp.mean(xf * xf, axis=-1, keepdims=True) + EPS) * g.astype(jnp.float32)
    return y.astype(x.dtype)


def causal_dwconv(h, w, b):
    L = h.shape[1]
    hp = jnp.pad(h, ((0, 0), (CONV_W - 1, 0), (0, 0)))
    y = b
    for k in range(CONV_W):
        y = y + hp[:, k:k + L, :] * w[k]
    return y


def conv_ffn(h, w_in, conv_w, conv_b, w_out):
    u = causal_dwconv(h @ w_in, conv_w, conv_b)
    gate, up = jnp.split(u, 2, axis=-1)
    return (jax.nn.silu(gate) * up) @ w_out


def _ssm_combine(e_i, e_j):
    ai_re, ai_im, bi_re, bi_im = e_i
    aj_re, aj_im, bj_re, bj_im = e_j
    a_re = aj_re * ai_re - aj_im * ai_im
    a_im = aj_re * ai_im + aj_im * ai_re
    b_re = aj_re * bi_re - aj_im * bi_im + bj_re
    b_im = aj_re * bi_im + aj_im * bi_re + bj_im
    return (a_re, a_im, b_re, b_im)


def s5_mixer(h, lam_re, lam_im, log_dt, b_re, b_im, c_re, c_im, d_skip, w_glu):
    dtype = h.dtype
    bsz, L, _ = h.shape
    f32 = jnp.float32
    u = h.astype(f32).reshape(bsz, L, N_GROUPS, SSM_GROUP)
    lr = lam_re.astype(f32)
    li = lam_im.astype(f32)
    dt = jnp.exp(log_dt.astype(f32))[:, None]
    mag = jnp.exp(lr * dt)
    lb_re = mag * jnp.cos(li * dt)
    lb_im = mag * jnp.sin(li * dt)
    den = lr * lr + li * li
    nr = lb_re - 1.0
    fr = ((nr * lr + lb_im * li) / den)[..., None]
    fi = ((lb_im * lr - nr * li) / den)[..., None]
    br = b_re.astype(f32)
    bi = b_im.astype(f32)
    bb_re = fr * br - fi * bi
    bb_im = fr * bi + fi * br
    bu_re = jnp.einsum('blgh,gph->blgp', u, bb_re)
    bu_im = jnp.einsum('blgh,gph->blgp', u, bb_im)
    a_re = jnp.broadcast_to(lb_re[None, None], (1, L, N_GROUPS, SSM_STATE))
    a_im = jnp.broadcast_to(lb_im[None, None], (1, L, N_GROUPS, SSM_STATE))
    _, _, s_re, s_im = lax.associative_scan(_ssm_combine, (a_re, a_im, bu_re, bu_im), axis=1)
    y = (jnp.einsum('blgp,ghp->blgh', s_re, c_re.astype(f32))
         - jnp.einsum('blgp,ghp->blgh', s_im, c_im.astype(f32)))
    y = y.reshape(bsz, L, D_MODEL) + d_skip.astype(f32) * u.reshape(bsz, L, D_MODEL)
    y = jax.nn.gelu(y)
    z_a, z_g = jnp.split(y @ w_glu.astype(f32), 2, axis=-1)
    return (z_a * jax.nn.sigmoid(z_g)).astype(dtype)


def fox_shared_kv(h_kv, w_kvf, b_f):
    bsz, L, _ = h_kv.shape
    z = h_kv @ w_kvf
    k = z[..., :D_MODEL].reshape(bsz, L, N_HEADS, HEAD_DIM)
    v = z[..., D_MODEL:2 * D_MODEL].reshape(bsz, L, N_HEADS, HEAD_DIM)
    f_logit = z[..., 2 * D_MODEL:].astype(jnp.float32) + b_f.astype(jnp.float32)
    cum = jnp.cumsum(jax.nn.log_sigmoid(f_logit), axis=1)
    return k, v, cum


def fox_attention(h, w_q, w_o, k, v, cum):
    dtype = h.dtype
    bsz, L, _ = h.shape
    nb = L // Q_BLOCK
    f32 = jnp.float32
    q = (h @ w_q).reshape(bsz, nb, Q_BLOCK, N_HEADS, HEAD_DIM).transpose(1, 0, 2, 3, 4)
    cq = cum.reshape(bsz, nb, Q_BLOCK, N_HEADS).transpose(1, 0, 2, 3)
    kf = k.astype(f32)
    vf = v.astype(f32)
    ck = cum.transpose(0, 2, 1)[:, :, None, :]
    kpos = jnp.arange(L, dtype=jnp.int32)
    starts = jnp.arange(nb, dtype=jnp.int32) * Q_BLOCK

    def one_block(args):
        qb, cqb, start = args
        s = jnp.einsum('bqhd,bkhd->bhqk', qb.astype(f32), kf) * ATTN_SCALE
        s = s + cqb.transpose(0, 2, 1)[..., None] - ck
        qpos = start + jnp.arange(Q_BLOCK, dtype=jnp.int32)
        mask = kpos[None, :] <= qpos[:, None]
        s = jnp.where(mask, s, -jnp.inf)
        p = jax.nn.softmax(s, axis=-1)
        return jnp.einsum('bhqk,bkhd->bqhd', p, vf)

    o = lax.map(one_block, (q, cq, starts))
    o = o.transpose(1, 0, 2, 3, 4).reshape(bsz, L, D_MODEL)
    return o.astype(dtype) @ w_o


def setup_inputs(seed: int = 0) -> dict:
    key = jax.random.key(seed)
    ks = jax.random.split(key, 24)
    nrm = jax.random.normal
    D, G, P, H, F = D_MODEL, N_GROUPS, SSM_STATE, SSM_GROUP, D_FF
    x = nrm(ks[0], (BATCH, SEQ, D), jnp.float32)
    g_mix = 1.0 + 0.02 * nrm(ks[1], (DEPTH, D), jnp.float32)
    g_ffn = 1.0 + 0.02 * nrm(ks[2], (DEPTH, D), jnp.float32)
    lam_re = -0.5 + 0.01 * nrm(ks[3], (N_A_LAYERS, G, P), jnp.float32)
    lam_im = (math.pi * jnp.arange(P, dtype=jnp.float32))[None, None, :] + 0.01 * nrm(ks[4], (N_A_LAYERS, G, P), jnp.float32)
    log_dt = jax.random.uniform(ks[5], (N_A_LAYERS, G), jnp.float32, math.log(DT_MIN), math.log(DT_MAX))
    ssm_b_re = nrm(ks[6], (N_A_LAYERS, G, P, H), jnp.float32) * (2 * H) ** -0.5
    ssm_b_im = nrm(ks[7], (N_A_LAYERS, G, P, H), jnp.float32) * (2 * H) ** -0.5
    ssm_c_re = nrm(ks[8], (N_A_LAYERS, G, H, P), jnp.float32) * P ** -0.5
    ssm_c_im = nrm(ks[9], (N_A_LAYERS, G, H, P), jnp.float32) * P ** -0.5
    ssm_d = nrm(ks[10], (N_A_LAYERS, D), jnp.float32)
    w_glu = nrm(ks[11], (N_A_LAYERS, D, 2 * D), jnp.float32) * D ** -0.5
    g_kv = 1.0 + 0.02 * nrm(ks[12], (D,), jnp.float32)
    w_kvf = nrm(ks[13], (D, 2 * D + N_HEADS), jnp.float32) * D ** -0.5
    b_f = 2.0 + 0.5 * nrm(ks[14], (N_HEADS,), jnp.float32)
    w_q = nrm(ks[15], (N_B_LAYERS, D, D), jnp.float32) * D ** -0.5
    w_o = nrm(ks[16], (N_B_LAYERS, D, D), jnp.float32) * D ** -0.5
    w_ffn_in = nrm(ks[17], (DEPTH, D, 2 * F), jnp.float32) * D ** -0.5
    ffn_conv_w = nrm(ks[18], (DEPTH, CONV_W, 2 * F), jnp.float32) * CONV_W ** -0.5
    ffn_conv_b = 0.01 * nrm(ks[19], (DEPTH, 2 * F), jnp.float32)
    w_ffn_out = nrm(ks[20], (DEPTH, F, D), jnp.float32) * F ** -0.5
    g_final = 1.0 + 0.02 * nrm(ks[21], (D,), jnp.float32)
    return {"x": x, "g_mix": g_mix, "g_ffn": g_ffn, "lam_re": lam_re, "lam_im": lam_im,
            "log_dt": log_dt, "ssm_b_re": ssm_b_re, "ssm_b_im": ssm_b_im, "ssm_c_re": ssm_c_re,
            "ssm_c_im": ssm_c_im, "ssm_d": ssm_d, "w_glu": w_glu, "g_kv": g_kv, "w_kvf": w_kvf,
            "b_f": b_f, "w_q": w_q, "w_o": w_o, "w_ffn_in": w_ffn_in, "ffn_conv_w": ffn_conv_w,
            "ffn_conv_b": ffn_conv_b, "w_ffn_out": w_ffn_out, "g_final": g_final}


def reference(x, g_mix, g_ffn, lam_re, lam_im, log_dt, ssm_b_re, ssm_b_im, ssm_c_re, ssm_c_im,
              ssm_d, w_glu, g_kv, w_kvf, b_f, w_q, w_o, w_ffn_in, ffn_conv_w, ffn_conv_b,
              w_ffn_out, g_final):
    h = x
    k = v = cum = None
    for layer in range(DEPTH):
        if layer < N_A_LAYERS:
            h = h + s5_mixer(rmsnorm(h, g_mix[layer]), lam_re[layer], lam_im[layer], log_dt[layer],
                             ssm_b_re[layer], ssm_b_im[layer], ssm_c_re[layer], ssm_c_im[layer],
                             ssm_d[layer], w_glu[layer])
        else:
            if layer == N_A_LAYERS:
                k, v, cum = fox_shared_kv(rmsnorm(h, g_kv), w_kvf, b_f)
            j = layer - N_A_LAYERS
            h = h + fox_attention(rmsnorm(h, g_mix[layer]), w_q[j], w_o[j], k, v, cum)
        h = h + conv_ffn(rmsnorm(h, g_ffn[layer]), w_ffn_in[layer], ffn_conv_w[layer],
                         ffn_conv_b[layer], w_ffn_out[layer])
    return rmsnorm(h, g_final)
```

```cpp
#include <hip/hip_runtime.h>
#include <hip/hip_cooperative_groups.h>
#include <cstdio>
#include <cstdint>
namespace cg = cooperative_groups;
namespace pg8 {
#define PG8_LAS __attribute__((address_space(3)))
typedef unsigned short bf16_t;
typedef short bf16x8 __attribute__((ext_vector_type(8)));
typedef float f32x4 __attribute__((ext_vector_type(4)));
typedef unsigned u32x4 __attribute__((ext_vector_type(4)));
constexpr int BM = 256, BK = 64, HALF = 128, HTB = HALF * BK * 2  , STAGE_BYTES = 8 * HTB, NXCD = 8, WGM = 4;

__host__ __device__ __forceinline__ int lds_byte(int r, int c) { const int st = (r >> 4) * 2 + (c >> 5), rr = r & 15, cc = c & 31, ob = rr * 64 + cc * 2; return st * 1024 + (ob ^ (((ob >> 9) & 1) << 5)); }
__host__ __device__ __forceinline__ void stage_rc(int b, int& R, int& C) { const int st = b / 1024, sb = b % 1024, swz = sb ^ (((sb >> 9) & 1) << 5); R = (st >> 1) * 16 + swz / 64; C = (st & 1) * 32 + (swz % 64) / 2; }
__host__ __device__ __forceinline__ int perm32(int rho) { const int n = rho >> 4, i = rho & 15; return 8 * (i >> 2) + 4 * n + (i & 3); }

struct Unit { int pm, pn; };
struct Gemm { const bf16_t* A; const bf16_t* Bt; int M, N, K; int a_tile_rows; };

struct StaticOrder {
    int nM, nN, nwg, G, c;
    __host__ __device__ void init(int M, int N, int G_, int c_) { nM = M / BM; nN = N / BM; nwg = nM * nN; G = G_; c = c_; }
    __host__ __device__ void init2(int nM_, int nN_, int G_, int c_) { nM = nM_; nN = nN_; nwg = nM * nN; G = G_; c = c_; }
    __host__ __device__ bool next(int i, Unit& u) const {
        const long L = (long)i * G + c; if (L >= nwg) return false;
        int wgid = (int)L; { const int q = nwg / NXCD, r = nwg % NXCD, xcd = wgid % NXCD, off = wgid / NXCD; wgid = (xcd < r ? xcd * (q + 1) : r * (q + 1) + (xcd - r) * q) + off; }
        const int nig = WGM * nN, gid = wgid / nig, fm = gid * WGM, gsz = (nM - fm) < WGM ? (nM - fm) : WGM;
        u.pm = fm + ((wgid % nig) % gsz); u.pn = (wgid % nig) / gsz; return true;
    }
    __device__ __forceinline__ void a_ready(const Unit&) const {}
    __device__ __forceinline__ void done(const Unit&) const {}
};

__device__ __forceinline__ unsigned cvt_pk_bf16(float lo, float hi) { unsigned r; asm volatile("v_cvt_pk_bf16_f32 %0, %1, %2" : "=v"(r) : "v"(lo), "v"(hi)); return r; }

template <class Epi, class Sched, bool ALIGN_EPI = false, bool SP2 = false>
__device__ __forceinline__ void gemm_phase(PG8_LAS unsigned char* lds, const Gemm g, const Sched& S, const Epi& E) {
    int tid_l = threadIdx.x; asm volatile("" : "+v"(tid_l)); const int tid = tid_l, wid = __builtin_amdgcn_readfirstlane(tid >> 6), lane = tid & 63, wr = wid >> 2, wc = wid & 3, fr = lane & 15, fq = lane >> 4;
    const int K = g.K, nt = K / BK;
    unsigned voffA[2], voffB[2];
#pragma unroll
    for (int i = 0; i < 2; ++i) { int R, C; stage_rc(tid * 16 + i * 8192, R, C); const int Rb = Epi::PERM ? ((R & ~31) + perm32(R & 31)) : R;
        voffA[i] = (unsigned)(R * K + C) * 2u; voffB[i] = (unsigned)(Rb * K + C) * 2u; }
    const size_t kstep = (size_t)(BK * 2);
    const size_t hstep = (size_t)HALF * K * 2;
    const size_t tstep = 2 * hstep; const size_t tstepA = (size_t)g.a_tile_rows * K * 2;
    const unsigned ldsw = (unsigned)wid * 1024u;
    const int aoff = lds_byte(wr * 64 + fr, fq * 8), boff = lds_byte(wc * 32 + fr, fq * 8);
#define PG8_SA(b, h) (((b) * 2 + (h)) * HTB)
#define PG8_SB(b, h) ((4 + (b) * 2 + (h)) * HTB)
#define PG8_STAGE(bufoff, gbase, voff) do { _Pragma("unroll") for (int _i = 0; _i < 2; ++_i) \
        __builtin_amdgcn_global_load_lds((const unsigned*)((const char*)(gbase) + (voff)[_i]), (PG8_LAS unsigned*)(lds + (bufoff) + ldsw + _i * 8192), 16, 0, 0); } while (0)
#define PG8_LDA(dst, b, h) do { _Pragma("unroll") for (int m = 0; m < 4; ++m) _Pragma("unroll") for (int k = 0; k < 2; ++k) dst[m][k] = *(const PG8_LAS bf16x8*)(lds + PG8_SA(b, h) + aoff + m * 2048 + k * 1024); } while (0)
#define PG8_LDB(dst, b, h) do { _Pragma("unroll") for (int n = 0; n < 2; ++n) _Pragma("unroll") for (int k = 0; k < 2; ++k) dst[n][k] = *(const PG8_LAS bf16x8*)(lds + PG8_SB(b, h) + boff + n * 2048 + k * 1024); } while (0)
#define PG8_MMA(ai, bj, At, Bt) do { __builtin_amdgcn_s_setprio(1); _Pragma("unroll") for (int m = 0; m < 4; ++m) _Pragma("unroll") for (int n = 0; n < 2; ++n) _Pragma("unroll") for (int k = 0; k < 2; ++k) \
        acc[ai][bj][m][n] = __builtin_amdgcn_mfma_f32_16x16x32_bf16(Bt[n][k], At[m][k], acc[ai][bj][m][n], 0, 0, 0); __builtin_amdgcn_s_setprio(0); } while (0)
#define PG8_WAIT_V(n) asm volatile("s_waitcnt vmcnt(" #n ")" ::: "memory")
#define PG8_WAIT_L(n) asm volatile("s_waitcnt lgkmcnt(" #n ")" ::: "memory")
#define PG8_BAR __builtin_amdgcn_s_barrier()
#define PG8_SCHED __builtin_amdgcn_sched_barrier(0)
    Unit cur, nxt; int ui = 0;
    if (!S.next(0, cur)) return;
    f32x4 acc[2][2][4][2];
#pragma unroll
    for (int a = 0; a < 2; ++a)
#pragma unroll
        for (int b = 0; b < 2; ++b)
#pragma unroll
            for (int m = 0; m < 4; ++m)
#pragma unroll
                for (int n = 0; n < 2; ++n) acc[a][b][m][n] = (f32x4){0.f, 0.f, 0.f, 0.f};
    bf16x8 At[4][2], B0[2][2], B1[2][2];
    const char* cA = (const char*)g.A + (size_t)cur.pm * tstepA; const char* cB = (const char*)g.Bt + (size_t)cur.pn * tstep;
    S.a_ready(cur);
    if constexpr (SP2) {
        PG8_STAGE(PG8_SB(0, 0), cB, voffB); PG8_STAGE(PG8_SB(0, 1), cB + hstep, voffB); PG8_STAGE(PG8_SA(0, 0), cA, voffA); PG8_STAGE(PG8_SA(0, 1), cA + hstep, voffA);
        if (wr == 1) PG8_BAR;
        PG8_WAIT_V(2); PG8_BAR;
        PG8_STAGE(PG8_SB(1, 0), cB + kstep, voffB); PG8_STAGE(PG8_SA(1, 0), cA + kstep, voffA); PG8_STAGE(PG8_SB(1, 1), cB + hstep + kstep, voffB);
        PG8_WAIT_V(6); PG8_BAR;
    } else {
        PG8_STAGE(PG8_SB(0, 0), cB, voffB); PG8_STAGE(PG8_SA(0, 0), cA, voffA); PG8_STAGE(PG8_SB(0, 1), cB + hstep, voffB); PG8_STAGE(PG8_SA(0, 1), cA + hstep, voffA);
        if (wr == 1) PG8_BAR;
        PG8_WAIT_V(4); PG8_BAR;
        PG8_STAGE(PG8_SB(1, 0), cB + kstep, voffB); PG8_STAGE(PG8_SA(1, 0), cA + kstep, voffA); PG8_STAGE(PG8_SB(1, 1), cB + hstep + kstep, voffB);
        PG8_WAIT_V(6); PG8_BAR;
    }
    for (;;) {
        const bool has_next = S.next(ui + 1, nxt);
        const char* nA = has_next ? (const char*)g.A + (size_t)nxt.pm * tstepA : cA; const char* nB = has_next ? (const char*)g.Bt + (size_t)nxt.pn * tstep : cB;
        for (int t = 0; t < nt; t += 2) {
            const bool last = (t == nt - 2);
            const char* a1 = cA + (size_t)(t + 1) * kstep;
            const char* a2 = last ? nA : cA + (size_t)(t + 2) * kstep; const char* b2 = last ? nB : cB + (size_t)(t + 2) * kstep;
            const char* a3 = a2 + kstep; const char* b3 = b2 + kstep;
            if (last && has_next) S.a_ready(nxt);
            if constexpr (SP2) {
            PG8_LDB(B0, 0, 0); PG8_LDB(B1, 0, 1); PG8_SCHED; PG8_LDA(At, 0, 0); PG8_STAGE(PG8_SA(1, 1), a1 + hstep, voffA);
            PG8_WAIT_V(8); PG8_WAIT_L(0); PG8_BAR; PG8_MMA(0, 0, At, B0); PG8_MMA(0, 1, At, B1); PG8_BAR; PG8_SCHED;
            PG8_LDA(At, 0, 1); PG8_STAGE(PG8_SB(0, 0), b2, voffB); PG8_STAGE(PG8_SB(0, 1), b2 + hstep, voffB); PG8_STAGE(PG8_SA(0, 0), a2, voffA);
            PG8_WAIT_V(8); PG8_WAIT_L(0); PG8_BAR; PG8_MMA(1, 0, At, B0); PG8_MMA(1, 1, At, B1); PG8_BAR; PG8_SCHED;
            PG8_LDB(B0, 1, 0); PG8_LDB(B1, 1, 1); PG8_SCHED; PG8_LDA(At, 1, 0); PG8_STAGE(PG8_SA(0, 1), a2 + hstep, voffA);
            PG8_WAIT_V(8); PG8_WAIT_L(0); PG8_BAR; PG8_MMA(0, 0, At, B0); PG8_MMA(0, 1, At, B1); PG8_BAR; PG8_SCHED;
            PG8_LDA(At, 1, 1); PG8_STAGE(PG8_SB(1, 0), b3, voffB); PG8_STAGE(PG8_SB(1, 1), b3 + hstep, voffB); PG8_STAGE(PG8_SA(1, 0), a3, voffA);
            PG8_WAIT_V(8); PG8_WAIT_L(0); PG8_BAR; PG8_MMA(1, 0, At, B0); PG8_MMA(1, 1, At, B1); PG8_BAR; PG8_SCHED;
            } else {
            PG8_LDB(B0, 0, 0); PG8_SCHED; PG8_LDA(At, 0, 0); PG8_STAGE(PG8_SA(1, 1), a1 + hstep, voffA);
            PG8_WAIT_L(8); PG8_BAR; PG8_WAIT_L(0); PG8_MMA(0, 0, At, B0); PG8_BAR; PG8_SCHED;
            PG8_LDB(B1, 0, 1); PG8_STAGE(PG8_SB(0, 0), b2, voffB);
            PG8_BAR; PG8_WAIT_L(0); PG8_MMA(0, 1, At, B1); PG8_BAR;
            PG8_LDA(At, 0, 1); PG8_STAGE(PG8_SA(0, 0), a2, voffA);
            PG8_BAR; PG8_WAIT_L(0); PG8_MMA(1, 0, At, B0); PG8_BAR; PG8_SCHED;
            PG8_STAGE(PG8_SB(0, 1), b2 + hstep, voffB);
            PG8_WAIT_V(6); PG8_BAR; PG8_MMA(1, 1, At, B1); PG8_BAR;
            PG8_LDB(B0, 1, 0); PG8_SCHED; PG8_LDA(At, 1, 0); PG8_STAGE(PG8_SA(0, 1), a2 + hstep, voffA);
            PG8_WAIT_L(8); PG8_BAR; PG8_WAIT_L(0); PG8_MMA(0, 0, At, B0); PG8_BAR; PG8_SCHED;
            PG8_LDB(B1, 1, 1); PG8_STAGE(PG8_SB(1, 0), b3, voffB);
            PG8_BAR; PG8_WAIT_L(0); PG8_MMA(0, 1, At, B1); PG8_BAR;
            PG8_LDA(At, 1, 1); PG8_STAGE(PG8_SA(1, 0), a3, voffA);
            PG8_BAR; PG8_WAIT_L(0); PG8_MMA(1, 0, At, B0); PG8_BAR; PG8_SCHED;
            PG8_STAGE(PG8_SB(1, 1), b3 + hstep, voffB);
            PG8_WAIT_V(6); PG8_BAR; PG8_MMA(1, 1, At, B1); PG8_BAR;
            }
        }
        if constexpr (ALIGN_EPI) { if (wr == 0) PG8_BAR; }
        if constexpr (!Epi::AFTER_DRAIN) { E(acc, cur, wr, wc, fr, fq); S.done(cur); }
        if (!has_next) break;
#pragma unroll
        for (int a = 0; a < 2; ++a)
#pragma unroll
            for (int b = 0; b < 2; ++b)
#pragma unroll
                for (int m = 0; m < 4; ++m)
#pragma unroll
                    for (int n = 0; n < 2; ++n) acc[a][b][m][n] = (f32x4){0.f, 0.f, 0.f, 0.f};
        cur = nxt; cA = nA; cB = nB; ++ui;
        if constexpr (ALIGN_EPI) { if (wr == 1) PG8_BAR; }
    }
    PG8_WAIT_V(0);
    if constexpr (!ALIGN_EPI) { if (wr == 0) PG8_BAR; }
    PG8_BAR;
    if constexpr (Epi::AFTER_DRAIN) { E.fused(acc, cur, wr, wc, fr, fq, lds, wid, lane); S.done(cur); }
#undef PG8_SA
#undef PG8_SB
#undef PG8_STAGE
#undef PG8_LDA
#undef PG8_LDB
#undef PG8_MMA
#undef PG8_WAIT_V
#undef PG8_WAIT_L
#undef PG8_BAR
#undef PG8_SCHED
}
}


#include <hip/hip_bf16.h>
#include <cmath>
namespace attn_body {
using bf16=__hip_bfloat16;
using bf16x8=__attribute__((ext_vector_type(8)))short;
using s16x4=__attribute__((ext_vector_type(4)))short;
using f32x16=__attribute__((ext_vector_type(16)))float;
using u32x4=__attribute__((ext_vector_type(4)))unsigned;
constexpr int BATCH=8,NHEAD=16,SEQ=4096,D=64,DM=NHEAD*D;
constexpr int NW=8,QBLK=32,QB=QBLK*NW,KVBLK=64,NQB=SEQ/QB;
constexpr int ATTN_PITCH=DM, ATTN_UNIT_ROWS=QB;
__device__ __forceinline__ int crow(int r,int hi){return (r&3)+8*(r>>2)+4*hi;}
#define SBAR() __builtin_amdgcn_sched_barrier(0)
__device__ __forceinline__ void cmask(f32x16&p0,f32x16&p1,int jb,int qrel,int hi){
  const float NEG=-INFINITY; int kb=64*jb+4*hi;
  #pragma unroll
  for(int r=0;r<16;++r){int kv=kb+(r&3)+8*(r>>2); if(kv>qrel)p0[r]=NEG; if(kv+32>qrel)p1[r]=NEG;}
}

constexpr int NSLOT=3, SLOTB=8192;
constexpr int LDS_K=0, LDS_V=NSLOT*SLOTB, LDS_WS=2*NSLOT*SLOTB, LDS_OST=LDS_WS+NW*64*4, LDS_BIAS=LDS_OST+NW*4096, LDS_BYTES=LDS_BIAS+SEQ*4+256;
constexpr float C2=0.125f*1.4426950408889634f;
__device__ __forceinline__ void glds16(const void*gsrc,unsigned lds_dst){unsigned keep;
  asm volatile("s_mov_b32 %0, m0\n\ts_mov_b32 m0, %2\n\ts_nop 0\n\tglobal_load_lds_dwordx4 %1, off\n\ts_mov_b32 m0, %0":"=&s"(keep):"v"(gsrc),"s"(lds_dst):"memory");}
__device__ __forceinline__ float max3f(float a,float b,float c){float r;asm("v_max3_f32 %0, %1, %2, %3":"=v"(r):"v"(a),"v"(b),"v"(c));return r;}
__device__ __forceinline__ float max2f(float a,float b){float r;asm("v_max_f32_e32 %0, %1, %2":"=v"(r):"v"(a),"v"(b));return r;}
__device__ __forceinline__ float fadd_s(float a,float b){float r;asm("v_add_f32_e32 %0, %1, %2":"=v"(r):"v"(a),"v"(b));return r;}
__device__ __forceinline__ float fsub_s(float a,float b){float r;asm("v_sub_f32_e32 %0, %1, %2":"=v"(r):"v"(a),"v"(b));return r;}
typedef float f32x2_t __attribute__((ext_vector_type(2))); typedef __bf16 bf16x2_t __attribute__((ext_vector_type(2)));
__device__ __forceinline__ unsigned cvtpk_s(float lo,float hi){f32x2_t v={lo,hi};bf16x2_t b=__builtin_convertvector(v,bf16x2_t);return __builtin_bit_cast(unsigned,b);}
#define WAIT_BAR(N) asm volatile("s_waitcnt vmcnt(" #N ") lgkmcnt(0)\n\ts_barrier":::"memory")

__device__ __forceinline__ void qkt(f32x16&p0,f32x16&p1,const char*Kslot,const bf16x8*qr,const f32x16&c0i,const f32x16&c1i,int r32,int hi){
  const char*kb=Kslot+hi*1024+r32*16;
  #pragma unroll
  for(int d0=0;d0<4;++d0){
    const bf16x8 b0=*reinterpret_cast<const bf16x8*>(kb+d0*2048);
    const bf16x8 b1=*reinterpret_cast<const bf16x8*>(kb+d0*2048+512);
    if(d0==0){p0=__builtin_amdgcn_mfma_f32_32x32x16_bf16(b0,qr[0],c0i,0,0,0);p1=__builtin_amdgcn_mfma_f32_32x32x16_bf16(b1,qr[0],c1i,0,0,0);}
    else{p0=__builtin_amdgcn_mfma_f32_32x32x16_bf16(b0,qr[d0],p0,0,0,0);p1=__builtin_amdgcn_mfma_f32_32x32x16_bf16(b1,qr[d0],p1,0,0,0);}}
}
typedef __attribute__((address_space(3))) const char* lds_cptr;
typedef short v4i16_t __attribute__((ext_vector_type(4)));
__device__ __forceinline__ void kload8(bf16x8*kf,lds_cptr kp){
  kf[0]=*(const __attribute__((address_space(3))) bf16x8*)(kp);      kf[1]=*(const __attribute__((address_space(3))) bf16x8*)(kp+512);
  kf[2]=*(const __attribute__((address_space(3))) bf16x8*)(kp+2048); kf[3]=*(const __attribute__((address_space(3))) bf16x8*)(kp+2560);
  kf[4]=*(const __attribute__((address_space(3))) bf16x8*)(kp+4096); kf[5]=*(const __attribute__((address_space(3))) bf16x8*)(kp+4608);
  kf[6]=*(const __attribute__((address_space(3))) bf16x8*)(kp+6144); kf[7]=*(const __attribute__((address_space(3))) bf16x8*)(kp+6656);
}
__device__ __forceinline__ void kload2(bf16x8*kf,lds_cptr kp,int j){ kf[2*j]=*(const __attribute__((address_space(3))) bf16x8*)(kp+j*2048); kf[2*j+1]=*(const __attribute__((address_space(3))) bf16x8*)(kp+j*2048+512); }
__device__ __forceinline__ s16x4 vtr(lds_cptr p){ return __builtin_bit_cast(s16x4,__builtin_amdgcn_ds_read_tr16_b64_v4i16((__attribute__((address_space(3))) v4i16_t*)p)); }
__device__ __forceinline__ float rowmax(const f32x16&p0,const f32x16&p1){
  float a=max3f(p0[0],p0[1],p1[0]),b=max3f(p0[2],p0[3],p1[1]);a=max3f(a,p1[2],p1[3]);
  #pragma unroll
  for(int r=4;r<16;r+=4){a=max3f(a,p0[r],p0[r+1]);b=max3f(b,p0[r+2],p0[r+3]);a=max3f(a,p1[r],p1[r+1]);b=max3f(b,p1[r+2],p1[r+3]);}
  const float m=max2f(a,b);
  auto rr=__builtin_amdgcn_permlane32_swap(__float_as_uint(m),__float_as_uint(m),false,false);
  return max2f(__uint_as_float(rr[0]),__uint_as_float(rr[1]));
}
__device__ __forceinline__ void pv(f32x16*o,int vb,bf16x8 pa0,bf16x8 pa1,bf16x8 pa2,bf16x8 pa3){
  #pragma unroll
  for(int d0=0;d0<2;++d0){s16x4 lo[4],hi[4];
    #pragma unroll
    for(int ks=0;ks<4;++ks){
      asm volatile("ds_read_b64_tr_b16 %0,%1 offset:%c2":"=&v"(lo[ks]):"v"(vb),"i"(d0*4096+ks*1024):"memory");
      asm volatile("ds_read_b64_tr_b16 %0,%1 offset:%c2":"=&v"(hi[ks]):"v"(vb),"i"(d0*4096+ks*1024+512):"memory");}
    asm volatile("s_waitcnt lgkmcnt(0)":::"memory");SBAR();
    #define PK(k) (bf16x8){lo[k][0],lo[k][1],lo[k][2],lo[k][3],hi[k][0],hi[k][1],hi[k][2],hi[k][3]}
    o[d0]=__builtin_amdgcn_mfma_f32_32x32x16_bf16(pa0,PK(0),o[d0],0,0,0);
    o[d0]=__builtin_amdgcn_mfma_f32_32x32x16_bf16(pa1,PK(1),o[d0],0,0,0);
    o[d0]=__builtin_amdgcn_mfma_f32_32x32x16_bf16(pa2,PK(2),o[d0],0,0,0);
    o[d0]=__builtin_amdgcn_mfma_f32_32x32x16_bf16(pa3,PK(3),o[d0],0,0,0);
    #undef PK
  }
}

#ifndef ATTN_STORE16
#define ATTN_STORE16(p,v) (*(__attribute__((address_space(1))) u32x4*)(p)=(v))
#endif
template<int THRL,bool BIAS> __device__ __forceinline__ void attn_unit(int b,int h,int qb,const bf16*Q,const bf16*__restrict__ K,const bf16*__restrict__ V,bf16*O,const float*LCbh,const float*KMAXbh,char*shm){
  int tid_l_=threadIdx.x; asm volatile("":"+v"(tid_l_)); const int tid=tid_l_,lane=tid&63,r32=lane&31,hi=lane>>5; const int wid=__builtin_amdgcn_readfirstlane(tid>>6);
  const long rowbase=(long)b*SEQ; const int q0=qb*QB;
  const bf16*Qw=Q+(rowbase+q0+wid*QBLK)*DM+h*D;
  const bf16*Kh=K+rowbase*DM+h*D,*Vh=V+rowbase*DM+h*D;
  const unsigned lds0=(unsigned)(uintptr_t)shm;
  float*wsf=(float*)(shm+LDS_WS)+wid*64;
  const unsigned kdst=lds0+LDS_K+wid*1024, vdst=lds0+LDS_V+wid*1024;
  #define DMA_K(t,slot) glds16(ksrc+(long)(t)*KVBLK*DM,(unsigned)__builtin_amdgcn_readfirstlane(kdst+(slot)))
  #define DMA_V(t,slot) glds16(vsrc+(long)(t)*KVBLK*DM,(unsigned)__builtin_amdgcn_readfirstlane(vdst+(slot)))
  const int vb0=(int)(lds0+LDS_V)+((lane>>4)&1)*32+(lane&3)*8+(4*hi+((lane&15)>>2))*64;
  const char*Kbase=shm+LDS_K; bf16x8 kf[8];
  const lds_cptr shm3=(lds_cptr)shm; const lds_cptr kp0=shm3+LDS_K+hi*1024+r32*16; const lds_cptr vp0=shm3+LDS_V+((lane>>4)&1)*32+(lane&3)*8+(4*hi+((lane&15)>>2))*64;
  typedef float f32x4b __attribute__((ext_vector_type(4)));
  #define BIASLD(B0,B1,t) do{ int hl_=hi; asm volatile("":"+v"(hl_)); const __attribute__((address_space(3))) f32x4b* bp_=(const __attribute__((address_space(3))) f32x4b*)(shm3+LDS_BIAS+boff+hl_*16+(t)*256); \
    _Pragma("unroll") for(int k_=0;k_<4;++k_){ const f32x4b x_=bp_[2*k_], y_=bp_[8+2*k_]; \
      if(BIAS){B0[4*k_]=x_[0]-mhat;B0[4*k_+1]=x_[1]-mhat;B0[4*k_+2]=x_[2]-mhat;B0[4*k_+3]=x_[3]-mhat; B1[4*k_]=y_[0]-mhat;B1[4*k_+1]=y_[1]-mhat;B1[4*k_+2]=y_[2]-mhat;B1[4*k_+3]=y_[3]-mhat;}else{B0[4*k_]=-mhat;B0[4*k_+1]=-mhat;B0[4*k_+2]=-mhat;B0[4*k_+3]=-mhat;B1[4*k_]=-mhat;B1[4*k_+1]=-mhat;B1[4*k_+2]=-mhat;B1[4*k_+3]=-mhat;} } }while(0)
  bf16x8 qr[4];
  #pragma unroll
  for(int d0=0;d0<4;++d0)qr[d0]=*(const __attribute__((address_space(1))) bf16x8*)(&Qw[(long)r32*DM+d0*16+hi*8]);
  int t0=0; const int NTF=(q0+QB)/KVBLK;
  if(BIAS){
    float qn=0.f;
    #pragma unroll
    for(int d0=0;d0<4;++d0){
      #pragma unroll
      for(int e=0;e<8;++e){ const float x=__builtin_bit_cast(float,(unsigned)(unsigned short)qr[d0][e]<<16); qn+=x*x; } }
    qn+=__shfl_xor(qn,32);
    #pragma unroll
    for(int o_=1;o_<32;o_<<=1)qn=fmaxf(qn,__shfl_xor(qn,o_));
    __attribute__((address_space(3))) float* qx=(__attribute__((address_space(3))) float*)(shm3+LDS_BIAS+SEQ*4+128);
    if(lane==0)qx[wid]=qn;
    asm volatile("s_waitcnt lgkmcnt(0)\n\ts_barrier":::"memory");
    float qmax2=0.f;
    #pragma unroll
    for(int w_=0;w_<NW;++w_)qmax2=fmaxf(qmax2,qx[w_]);
    const float kmax2=((const __attribute__((address_space(1))) float*)KMAXbh)[0]+((const __attribute__((address_space(1))) float*)KMAXbh)[1];
    const float Bqk=sqrtf(qmax2*kmax2)*1.02f;
    const __attribute__((address_space(3))) float* beta=(const __attribute__((address_space(3))) float*)(shm3+LDS_BIAS);
    const float thr=beta[q0]-(40.0f+2.0f*Bqk);
    int lo_=0,hi_=NTF-4;
    while(lo_<hi_){ const int mid_=(lo_+hi_)>>1; if(beta[64*mid_+63]<thr)lo_=mid_+1; else hi_=mid_; }
    t0=__builtin_amdgcn_readfirstlane(lo_&~1);
  }
  const int NT=NTF-t0;
  const bf16*ksrc=Kh+(long)(t0*KVBLK+lane)*DM+wid*8;
  const bf16*vsrc=Vh+(long)(t0*KVBLK+16*(wid&3)+(lane>>2))*DM+(wid>>2)*32+(lane&3)*8;
  const int boff=t0*256;
  DMA_K(0,0);DMA_V(0,0);DMA_K(1,SLOTB);
  float mhat=0.f,l_reg=0.f;f32x16 o[2];o[0]=f32x16{};o[1]=f32x16{};
  const int qrel=wid*QBLK+r32;
  #define CMASK(P0,P1,t) do{int jb_=(t)-(NT-4); if(jb_>=0)cmask(P0,P1,jb_,qrel,hi);}while(0)
  bool resc=false;
  #define START(P0,P1) do{ const float rm=rowmax(P0,P1); resc=false; \
    { const float dl=rm; mhat=fadd_s(mhat,dl); \
      _Pragma("unroll") for(int r=0;r<16;++r){P0[r]=fsub_s(P0[r],dl);P1[r]=fsub_s(P1[r],dl);} } \
    _Pragma("unroll") for(int r=0;r<16;++r)P0[r]=__builtin_amdgcn_exp2f(P0[r]); }while(0)
  #define RESC() do{ if(resc){ asm volatile("s_waitcnt lgkmcnt(0)":::"memory"); \
      _Pragma("unroll") for(int d_=0;d_<2;++d_) _Pragma("unroll") for(int r=0;r<16;++r)o[d_][r]*=wsf[crow(r,hi)]; } }while(0)
  f32x16 pA0,pA1,pB0,pB1;
  int sl_prev=0,sl_cur=0,sl_next=SLOTB;
  #define ROT() do{sl_prev=sl_cur;sl_cur=sl_next;sl_next=(sl_next==(NSLOT-1)*SLOTB)?0:sl_next+SLOTB;}while(0)
  DMA_K(2,2*SLOTB);
  WAIT_BAR(3);
  { f32x16 ci0,ci1; BIASLD(ci0,ci1,0); qkt(pA0,pA1,Kbase,qr,ci0,ci1,r32,hi); } asm volatile("s_nop 15\n\ts_nop 7":"+v"(pA0),"+v"(pA1));CMASK(pA0,pA1,0);
  START(pA0,pA1);
  _Pragma("unroll") for(int r=0;r<16;++r)pA1[r]=__builtin_amdgcn_exp2f(pA1[r]);
  WAIT_BAR(0);
  DMA_K(3,0);DMA_V(1,SLOTB);
  ROT();
  kload8(kf,kp0+sl_cur);
  WAIT_BAR(2);
  s16x4 vlo[8],vhi[8]; u32x4 pw0,pw1,pw2,pw3;
  #define PKW(P,B) cvtpk_s(P[B],P[B+1])
  #define PAF(k) __builtin_bit_cast(bf16x8,pw##k)
  #define VFR(i) (bf16x8){vlo[i][0],vlo[i][1],vlo[i][2],vlo[i][3],vhi[i][0],vhi[i][1],vhi[i][2],vhi[i][3]}
  #define PIN(x) asm volatile("":"+v"(x))
  #define MX3(a,b,c) __builtin_fmaxf(__builtin_fmaxf((a),(b)),(c))
  #define GAPA(MF,A0,A1,A2,A3,W0,W1,PW) do{ MF; sacc+=A0; sacc+=A1; sacc+=A2; sacc+=A3; PIN(sacc); W0; W1; PIN(PW); SBAR(); }while(0)
  #define EX(v) __builtin_amdgcn_exp2f(v)
  #define GAPB(MF,X,B) do{ MF; X[B]=EX(X[B]); X[B+1]=EX(X[B+1]); X[B+2]=EX(X[B+2]); X[B+3]=EX(X[B+3]); PIN(X); SBAR(); }while(0)
  #define VRD(i) do{ vlo[i]=vtr(vp_+(((i)>>2)*4096+((i)&3)*1024)); vhi[i]=vtr(vp_+(((i)>>2)*4096+((i)&3)*1024+512)); }while(0)
  #define KRD(G,j) do{ if(G){ kload2(kf,kp0+sl_next,j); SBAR(); } }while(0)
  #define STEP(C0,C1,P0,P1,t,GK,GV,GL) do{ SBAR(); BIASLD(C0,C1,t); SBAR(); \
    const lds_cptr vp_=vp0+sl_prev; \
    VRD(0); SBAR(); float sacc=(P0[0]+P0[1]); \
    GAPA(C0=__builtin_amdgcn_mfma_f32_32x32x16_bf16(kf[0],qr[0],C0,0,0,0), P0[2],P0[3],P0[4],P0[5],     pw0[0]=PKW(P0,0), pw0[1]=PKW(P0,2), pw0); \
    VRD(4); SBAR(); GAPA(C1=__builtin_amdgcn_mfma_f32_32x32x16_bf16(kf[1],qr[0],C1,0,0,0), P0[6],P0[7],P0[8],P0[9],     pw0[2]=PKW(P0,4), pw0[3]=PKW(P0,6), pw0); \
    VRD(1); SBAR(); GAPA(C0=__builtin_amdgcn_mfma_f32_32x32x16_bf16(kf[2],qr[1],C0,0,0,0),   P0[10],P0[11],P0[12],P0[13], pw1[0]=PKW(P0,8), pw1[1]=PKW(P0,10), pw1); \
    VRD(5); SBAR(); GAPA(C1=__builtin_amdgcn_mfma_f32_32x32x16_bf16(kf[3],qr[1],C1,0,0,0),   P0[14],P0[15],P1[0],P1[1],   pw1[2]=PKW(P0,12),pw1[3]=PKW(P0,14), pw1); \
    VRD(2); SBAR(); GAPA(C0=__builtin_amdgcn_mfma_f32_32x32x16_bf16(kf[4],qr[2],C0,0,0,0),   P1[2],P1[3],P1[4],P1[5],     pw2[0]=PKW(P1,0), pw2[1]=PKW(P1,2), pw2); \
    VRD(6); SBAR(); GAPA(C1=__builtin_amdgcn_mfma_f32_32x32x16_bf16(kf[5],qr[2],C1,0,0,0),   P1[6],P1[7],P1[8],P1[9],     pw2[2]=PKW(P1,4), pw2[3]=PKW(P1,6), pw2); \
    VRD(3); SBAR(); GAPA(C0=__builtin_amdgcn_mfma_f32_32x32x16_bf16(kf[6],qr[3],C0,0,0,0),   P1[10],P1[11],P1[12],P1[13], pw3[0]=PKW(P1,8), pw3[1]=PKW(P1,10), pw3); \
    VRD(7); SBAR(); GAPA(C1=__builtin_amdgcn_mfma_f32_32x32x16_bf16(kf[7],qr[3],C1,0,0,0),   P1[14],P1[15],0.f,0.f,       pw3[2]=PKW(P1,12),pw3[3]=PKW(P1,14), pw3); \
    l_reg+=sacc; \
    if(GK){DMA_K((t)+3,sl_cur);} if(GV){DMA_V((t)+1,sl_next);} \
    CMASK(C0,C1,t); \
    { float a=MX3(C0[0],C0[1],C1[0]),b=MX3(C0[2],C0[3],C1[1]); a=MX3(a,C1[2],C1[3]); \
      _Pragma("unroll") for(int r=4;r<16;r+=4){a=MX3(a,C0[r],C0[r+1]);b=MX3(b,C0[r+2],C0[r+3]);a=MX3(a,C1[r],C1[r+1]);b=MX3(b,C1[r+2],C1[r+3]);} \
      float rm=__builtin_fmaxf(a,b); { auto rr=__builtin_amdgcn_permlane32_swap(__float_as_uint(rm),__float_as_uint(rm),false,false); rm=__builtin_fmaxf(__uint_as_float(rr[0]),__uint_as_float(rr[1])); } \
      resc=false; \
      if(__builtin_expect(__any(rm>(float)THRL),0)){ const float dl=__builtin_fmaxf(rm,0.f); mhat+=dl; \
        _Pragma("unroll") for(int r=0;r<16;++r){C0[r]-=dl;C1[r]-=dl;} \
        const float f=__builtin_amdgcn_exp2f(-dl); l_reg*=f; if(hi==0)wsf[r32]=f; resc=true; } } \
    SBAR(); \
    GAPB(o[0]=__builtin_amdgcn_mfma_f32_32x32x16_bf16(PAF(0),VFR(0),o[0],0,0,0), C0,0); \
    GAPB(o[1]=__builtin_amdgcn_mfma_f32_32x32x16_bf16(PAF(0),VFR(4),o[1],0,0,0), C0,4); \
    KRD(GL,0); GAPB(o[0]=__builtin_amdgcn_mfma_f32_32x32x16_bf16(PAF(1),VFR(1),o[0],0,0,0), C0,8); \
    KRD(GL,1); GAPB(o[1]=__builtin_amdgcn_mfma_f32_32x32x16_bf16(PAF(1),VFR(5),o[1],0,0,0), C0,12); \
    KRD(GL,2); GAPB(o[0]=__builtin_amdgcn_mfma_f32_32x32x16_bf16(PAF(2),VFR(2),o[0],0,0,0), C1,0); \
    KRD(GL,3); GAPB(o[1]=__builtin_amdgcn_mfma_f32_32x32x16_bf16(PAF(2),VFR(6),o[1],0,0,0), C1,4); \
    GAPB(o[0]=__builtin_amdgcn_mfma_f32_32x32x16_bf16(PAF(3),VFR(3),o[0],0,0,0), C1,8); \
    GAPB(o[1]=__builtin_amdgcn_mfma_f32_32x32x16_bf16(PAF(3),VFR(7),o[1],0,0,0), C1,12); \
    }while(0)
  int t=1;
  #undef CMASK
  #define CMASK(P0,P1,t) do{}while(0)
  for(;t+5<NT;t+=2){
    STEP(pB0,pB1,pA0,pA1,t,true,true,true);     WAIT_BAR(2); RESC(); ROT();
    STEP(pA0,pA1,pB0,pB1,t+1,true,true,true);   WAIT_BAR(2); RESC(); ROT();
  }
  #undef CMASK
  #define CMASK(P0,P1,t) do{int jb_=(t)-(NT-4); if(jb_>=0)cmask(P0,P1,jb_,qrel,hi);}while(0)
  #define ENDW(tt) do{ if((tt)+3<NT){WAIT_BAR(2);} else if((tt)+2<NT){WAIT_BAR(1);} else {WAIT_BAR(0);} }while(0)
  for(;t+1<NT;t+=2){
    STEP(pB0,pB1,pA0,pA1,t,(t+3<NT),(t+1<NT),(t+1<NT));       ENDW(t);   RESC(); ROT();
    STEP(pA0,pA1,pB0,pB1,t+1,(t+4<NT),(t+2<NT),(t+2<NT));     ENDW(t+1); RESC(); ROT();
  }
  STEP(pB0,pB1,pA0,pA1,NT-1,false,false,false); RESC();
  { float sacc=pB0[0]+pB0[1]; _Pragma("unroll") for(int r=2;r<16;++r)sacc+=pB0[r]; _Pragma("unroll") for(int r=0;r<16;++r)sacc+=pB1[r]; l_reg+=sacc;
    pw0=(u32x4){PKW(pB0,0),PKW(pB0,2),PKW(pB0,4),PKW(pB0,6)};pw1=(u32x4){PKW(pB0,8),PKW(pB0,10),PKW(pB0,12),PKW(pB0,14)};pw2=(u32x4){PKW(pB1,0),PKW(pB1,2),PKW(pB1,4),PKW(pB1,6)};pw3=(u32x4){PKW(pB1,8),PKW(pB1,10),PKW(pB1,12),PKW(pB1,14)};
    SBAR(); pv(o,vb0+sl_cur,PAF(0),PAF(1),PAF(2),PAF(3)); }
  #undef PKW
  #undef PAF
  #undef VFR
  #undef PIN
  #undef MX3
  #undef GAPA
  #undef GAPB
  #undef EX
  #undef VRD
  #undef KRD
  #undef STEP
  #undef ENDW
  {auto rr=__builtin_amdgcn_permlane32_swap(__float_as_uint(l_reg),__float_as_uint(l_reg),false,false);l_reg=__uint_as_float(rr[0])+__uint_as_float(rr[1]);}
  if(hi==0)wsf[32+r32]=l_reg;asm volatile("s_waitcnt lgkmcnt(0)":::"memory");
  float rli[16];
  #pragma unroll
  for(int r=0;r<16;++r)rli[r]=__builtin_amdgcn_rcpf(wsf[32+crow(r,hi)]);
  bf16*Ow=O+(rowbase+q0+wid*QBLK)*DM+h*D;
  { bf16*stg=(bf16*)(shm+LDS_OST)+wid*2048;
    #pragma unroll
    for(int r=0;r<16;++r){const int orow=crow(r,hi);
      #pragma unroll
      for(int d0=0;d0<2;++d0)stg[orow*64+d0*32+r32]=__float2bfloat16(o[d0][r]*rli[r]);}
    asm volatile("s_waitcnt lgkmcnt(0)":::"memory");
    #pragma unroll
    for(int i=0;i<4;++i){const int row=i*8+(lane>>3),ch=lane&7; const u32x4 v=*(const u32x4*)(stg+row*64+ch*8); ATTN_STORE16(Ow+(long)row*DM+ch*8,v);} }
  asm volatile("s_waitcnt lgkmcnt(0)\n\ts_barrier":::"memory");
  #undef BIASLD
  #undef DMA_K
  #undef DMA_V
  #undef CMASK
  #undef START
  #undef RESC
  #undef ROT
}
constexpr int ATTN_LDS_BYTES=LDS_BYTES;
struct AttnTensors { const bf16* Q; const bf16* K; const bf16* V; bf16* O; const float* LC; const float* TOT; const float* KMAX; };
struct AttnUnit { int bh; int qb; };
struct StaticOrder {
  int vcu,G;
  __device__ __forceinline__ explicit StaticOrder(int grid,int block):vcu((grid%8==0)?(block%8)*(grid/8)+block/8:block),G(grid){}
  __device__ __forceinline__ bool next(int i,AttnUnit&u)const{
    if(G==256){ if(i>=8)return false; const int s=4*(vcu&1)+(i>>1); u.bh=vcu>>1; u.qb=(i&1)?15-s:s; return true; }
    const int U=i*G+vcu; if(U>=BATCH*NHEAD*NQB)return false; u.bh=U/NQB; u.qb=U%NQB; return true; }
  __device__ __forceinline__ void a_ready(const AttnUnit&)const{}
  __device__ __forceinline__ void done(const AttnUnit&)const{}
};
template<class Sched,int THRL=100,bool BIAS=true> __device__ __forceinline__ void attn_phase(char*lds,const AttnTensors&T,const Sched&S){
  AttnUnit u; int cur_bh=-1;
  for(int i=0;S.next(i,u);++i){ S.a_ready(u);
    if(u.bh!=cur_bh){
      cur_bh=u.bh; typedef float f32x4b __attribute__((ext_vector_type(4)));
      int tl_=threadIdx.x; asm volatile("":"+v"(tl_)); const int j0=tl_*8, c0=j0>>7; const float*TOTbh=T.TOT+u.bh*32; const float*LCbh=T.LC+(long)u.bh*SEQ;
      float off=0.f;
      #pragma unroll
      for(int c=0;c<32;++c){ const float tv=((const __attribute__((address_space(1))) float*)TOTbh)[c]; off+=(c<c0)?tv:0.f; }
      const f32x4b a=*(const __attribute__((address_space(1))) f32x4b*)(LCbh+j0), bq=*(const __attribute__((address_space(1))) f32x4b*)(LCbh+j0+4);
      __attribute__((address_space(3))) float* bt=(__attribute__((address_space(3))) float*)((__attribute__((address_space(3))) char*)lds+LDS_BIAS);
      *(__attribute__((address_space(3))) f32x4b*)(bt+j0)=(f32x4b){-(a[0]+off)*1.4426950408889634f,-(a[1]+off)*1.4426950408889634f,-(a[2]+off)*1.4426950408889634f,-(a[3]+off)*1.4426950408889634f};
      *(__attribute__((address_space(3))) f32x4b*)(bt+j0+4)=(f32x4b){-(bq[0]+off)*1.4426950408889634f,-(bq[1]+off)*1.4426950408889634f,-(bq[2]+off)*1.4426950408889634f,-(bq[3]+off)*1.4426950408889634f}; } attn_unit<THRL,BIAS>(u.bh/NHEAD,u.bh%NHEAD,u.qb,T.Q,T.K,T.V,T.O,T.LC+(long)u.bh*SEQ,T.KMAX+u.bh*2,lds); S.done(u); }
}
template<int THRL=100> __device__ __forceinline__ void attn_phase_dyn(char*lds,const AttnTensors&T,unsigned*counter){
  int cur_bh=-1;
  __attribute__((address_space(3))) unsigned* slot=(__attribute__((address_space(3))) unsigned*)((__attribute__((address_space(3))) char*)lds+LDS_BIAS+SEQ*4+192);
  for(;;){
    int tl_=threadIdx.x; asm volatile("":"+v"(tl_));
    if(tl_==0){ *slot=__hip_atomic_fetch_add(counter,1u,__ATOMIC_RELAXED,__HIP_MEMORY_SCOPE_AGENT); }
    asm volatile("s_waitcnt vmcnt(0) lgkmcnt(0)\n\ts_barrier":::"memory");
    const unsigned U=__builtin_amdgcn_readfirstlane(*slot);
    if(U>=(unsigned)(BATCH*NHEAD*NQB))break;
    const int bh=(int)(U>>4), qb=15-(int)(U&15);
    if(bh!=cur_bh){
      cur_bh=bh; typedef float f32x4b __attribute__((ext_vector_type(4)));
      const int j0=tl_*8, c0=j0>>7; const float*TOTbh=T.TOT+bh*32; const float*LCbh=T.LC+(long)bh*SEQ;
      float off=0.f;
      #pragma unroll
      for(int c=0;c<32;++c){ const float tv=((const __attribute__((address_space(1))) float*)TOTbh)[c]; off+=(c<c0)?tv:0.f; }
      const f32x4b a=*(const __attribute__((address_space(1))) f32x4b*)(LCbh+j0), bq=*(const __attribute__((address_space(1))) f32x4b*)(LCbh+j0+4);
      __attribute__((address_space(3))) float* bt=(__attribute__((address_space(3))) float*)((__attribute__((address_space(3))) char*)lds+LDS_BIAS);
      *(__attribute__((address_space(3))) f32x4b*)(bt+j0)=(f32x4b){-(a[0]+off)*1.4426950408889634f,-(a[1]+off)*1.4426950408889634f,-(a[2]+off)*1.4426950408889634f,-(a[3]+off)*1.4426950408889634f};
      *(__attribute__((address_space(3))) f32x4b*)(bt+j0+4)=(f32x4b){-(bq[0]+off)*1.4426950408889634f,-(bq[1]+off)*1.4426950408889634f,-(bq[2]+off)*1.4426950408889634f,-(bq[3]+off)*1.4426950408889634f}; }
    attn_unit<THRL,true>(bh/NHEAD,bh%NHEAD,qb,T.Q,T.K,T.V,T.O,T.LC+(long)bh*SEQ,T.KMAX+bh*2,lds);
  }
}
#undef SBAR
#undef WAIT_BAR
}

#define LAS __attribute__((address_space(3)))
#define GASP(T, p) ((__attribute__((address_space(1))) T*)(p))
namespace yk {
using pg8::f32x4; using pg8::u32x4; using pg8::bf16_t; using pg8::Unit; using pg8::BM; using pg8::HALF; using pg8::cvt_pk_bf16;
typedef unsigned u32x2 __attribute__((ext_vector_type(2)));
constexpr int M = 32768, D = 1024, SEQ = 4096, NBATCH = 8, NH = 16, HD = 64, FF = 2816, FF2 = 5632, NG = 64, NP = 64;
constexpr float EPS = 1e-6f;
constexpr float LOG2E = 1.4426950408889634f;
constexpr float C2 = 0.125f * LOG2E;
constexpr int FFM_TILES = 130;

constexpr size_t MiB = 1u << 20;
constexpr size_t WS_PART = 1 * MiB;
constexpr size_t WS_S5LB = 6 * MiB;
constexpr size_t WS_S5BB = 6 * MiB + 65536;
constexpr size_t WS_S5D = 7 * MiB + 512 * 1024;
constexpr size_t WS_WKV = 8 * MiB;
constexpr size_t WS_WQ = 12 * MiB;
constexpr size_t WS_WO = 16 * MiB;
constexpr size_t WS_WFI23 = 20 * MiB;
constexpr size_t WS_WFO23 = 42 * MiB;
constexpr size_t WS_WF = 53 * MiB;
constexpr size_t WS_LC = 54 * MiB;
constexpr size_t WS_TOT = 56 * MiB;
constexpr size_t WS_HB = 58 * MiB;
constexpr size_t WS_BUFA = 124 * MiB;
constexpr size_t WS_K = 189 * MiB, WS_V = 253 * MiB;
constexpr size_t WS_WGLU = WS_K;
constexpr size_t WS_WFI01 = WS_K + 8 * MiB;
constexpr size_t WS_WFO01 = WS_K + 30 * MiB;
constexpr size_t WS_S5W = WS_K + 44 * MiB;
constexpr size_t WS_S5V = WS_K + 60 * MiB;
constexpr size_t WS_S5K = WS_K + 76 * MiB;
constexpr size_t WS_S5A = WS_K + 78 * MiB;
constexpr size_t WS_ACT = 318 * MiB;
constexpr size_t WS_HALO = 496 * MiB;
constexpr size_t WS_END = 502 * MiB;

constexpr int RING_BYTES = 131072;
constexpr int XCH_OFF = RING_BYTES;
constexpr int LDS_BYTES = 147456;

__device__ __forceinline__ float wave_sum(float v) {
#pragma unroll
    for (int o = 1; o < 64; o <<= 1) v += __shfl_xor(v, o);
    return v;
}
__device__ __forceinline__ unsigned f2bf(float f) { unsigned u = __builtin_bit_cast(unsigned, f); return (u + 0x7fffu + ((u >> 16) & 1u)) >> 16; }
__device__ __forceinline__ unsigned pk2(float lo, float hi) { return f2bf(lo) | (f2bf(hi) << 16); }
__device__ __forceinline__ float bf2f(unsigned short b) { return __builtin_bit_cast(float, (unsigned)b << 16); }

__device__ __forceinline__ float rstd_from_part(const float* part, int row, int fq) {
    const f32x4 a = *GASP(const f32x4, part + (size_t)row * 32 + 4 * fq);
    const f32x4 b = *GASP(const f32x4, part + (size_t)row * 32 + 16 + 4 * fq);
    float s = ((a[0] + a[1]) + (a[2] + a[3])) + ((b[0] + b[1]) + (b[2] + b[3]));
    s += __shfl_xor(s, 16); s += __shfl_xor(s, 32);
    return rsqrtf(s * (1.0f / D) + EPS);
}
__device__ __forceinline__ float rstd_row_wave(const float* part, int row, int lane) {
    float s = (lane < 32) ? part[(size_t)row * 32 + lane] : 0.f;
    s = wave_sum(s);
    return rsqrtf(s * (1.0f / D) + EPS);
}

struct EpiRes {
    static constexpr bool PERM = true, AFTER_DRAIN = false;
    bf16_t* hb; float* part;
    __device__ __forceinline__ void operator()(const f32x4 (&acc)[2][2][4][2], const Unit& u, int wr, int wc, int fr_in, int fq_in) const {
        int ln_ = threadIdx.x & 63; asm volatile("" : "+v"(ln_)); const int fr = ln_ & 15, fq = ln_ >> 4; (void)fr_in; (void)fq_in;
        const int col0 = u.pn * BM + wc * 32 + 8 * fq;
#pragma unroll
        for (int ai = 0; ai < 2; ++ai)
#pragma unroll
            for (int m = 0; m < 4; ++m) {
                const int row = u.pm * BM + ai * HALF + wr * 64 + m * 16 + fr; float ss = 0.f;
#pragma unroll
                for (int bj = 0; bj < 2; ++bj) {
                    const size_t off = (size_t)row * D + col0 + bj * HALF;
                    const u32x4 hw = *GASP(const u32x4, hb + off);
                    f32x4 a, b;
                    a[0] = __builtin_bit_cast(float, hw.x << 16); a[1] = __builtin_bit_cast(float, hw.x & 0xffff0000u); a[2] = __builtin_bit_cast(float, hw.y << 16); a[3] = __builtin_bit_cast(float, hw.y & 0xffff0000u);
                    b[0] = __builtin_bit_cast(float, hw.z << 16); b[1] = __builtin_bit_cast(float, hw.z & 0xffff0000u); b[2] = __builtin_bit_cast(float, hw.w << 16); b[3] = __builtin_bit_cast(float, hw.w & 0xffff0000u);
                    a += acc[ai][bj][m][0]; b += acc[ai][bj][m][1];
                    u32x4 w; w.x = cvt_pk_bf16(a[0], a[1]); w.y = cvt_pk_bf16(a[2], a[3]); w.z = cvt_pk_bf16(b[0], b[1]); w.w = cvt_pk_bf16(b[2], b[3]);
                    *GASP(u32x4, hb + off) = w;
                    ss += (a[0] * a[0] + a[1] * a[1]) + (a[2] * a[2] + a[3] * a[3]) + (b[0] * b[0] + b[1] * b[1]) + (b[2] * b[2] + b[3] * b[3]);
                }
                ss += __shfl_xor(ss, 16); ss += __shfl_xor(ss, 32);
                if (fq == 0) *GASP(float, part + (size_t)row * 32 + u.pn * 4 + wc) = ss;
                else if (fq == 1) *GASP(float, part + (size_t)row * 32 + 16 + u.pn * 4 + wc) = 0.f;
            }
    }
};
struct EpiGlu {
    static constexpr bool PERM = true, AFTER_DRAIN = false;
    const float* hin32; bf16_t* hb; float* part;
    __device__ __forceinline__ void operator()(const f32x4 (&acc)[2][2][4][2], const Unit& u, int wr, int wc, int fr_in, int fq_in) const {
        int ln_ = threadIdx.x & 63; asm volatile("" : "+v"(ln_)); const int fr = ln_ & 15, fq = ln_ >> 4; (void)fr_in; (void)fq_in;
        const int col0 = u.pn * 128 + wc * 32 + 8 * fq;
#pragma unroll
        for (int ai = 0; ai < 2; ++ai)
#pragma unroll
            for (int m = 0; m < 4; ++m) {
                const int row = u.pm * BM + ai * HALF + wr * 64 + m * 16 + fr; float ss = 0.f;
                const size_t off = (size_t)row * D + col0;
                f32x4 v[2];
                if (hin32) { v[0] = *GASP(const f32x4, hin32 + off); v[1] = *GASP(const f32x4, hin32 + off + 4); }
                else { const u32x4 hw = *GASP(const u32x4, hb + off);
                    v[0][0] = __builtin_bit_cast(float, hw.x << 16); v[0][1] = __builtin_bit_cast(float, hw.x & 0xffff0000u); v[0][2] = __builtin_bit_cast(float, hw.y << 16); v[0][3] = __builtin_bit_cast(float, hw.y & 0xffff0000u);
                    v[1][0] = __builtin_bit_cast(float, hw.z << 16); v[1][1] = __builtin_bit_cast(float, hw.z & 0xffff0000u); v[1][2] = __builtin_bit_cast(float, hw.w << 16); v[1][3] = __builtin_bit_cast(float, hw.w & 0xffff0000u); }
#pragma unroll
                for (int n = 0; n < 2; ++n) {
                    const f32x4 a = acc[ai][0][m][n], g = acc[ai][1][m][n];
                    f32x4 x = v[n];
#pragma unroll
                    for (int e = 0; e < 4; ++e) x[e] += a[e] * __builtin_amdgcn_rcpf(1.0f + __expf(-g[e]));
                    v[n] = x;
                    ss += (x[0] * x[0] + x[1] * x[1]) + (x[2] * x[2] + x[3] * x[3]);
                }
                u32x4 w; w.x = cvt_pk_bf16(v[0][0], v[0][1]); w.y = cvt_pk_bf16(v[0][2], v[0][3]); w.z = cvt_pk_bf16(v[1][0], v[1][1]); w.w = cvt_pk_bf16(v[1][2], v[1][3]);
                *GASP(u32x4, hb + off) = w;
                ss += __shfl_xor(ss, 16); ss += __shfl_xor(ss, 32);
                if (fq == 0) *GASP(float, part + (size_t)row * 32 + u.pn * 4 + wc) = ss;
            }
    }
};
struct EpiScale {
    static constexpr bool PERM = true, AFTER_DRAIN = false;
    bf16_t* O0; bf16_t* O1; const float* part; float cs; unsigned* kmax;
    __device__ __forceinline__ void operator()(const f32x4 (&acc)[2][2][4][2], const Unit& u, int wr, int wc, int fr_in, int fq_in) const {
        int ln_ = threadIdx.x & 63; asm volatile("" : "+v"(ln_)); const int fr = ln_ & 15, fq = ln_ >> 4; (void)fr_in; (void)fq_in;
        bf16_t* base = (u.pn < 4) ? O0 : O1; const int col0 = (u.pn & 3) * BM + wc * 32 + 8 * fq;
        float km[2] = {0.f, 0.f};
#pragma unroll
        for (int ai = 0; ai < 2; ++ai)
#pragma unroll
            for (int m = 0; m < 4; ++m) {
                const int row = u.pm * BM + ai * HALF + wr * 64 + m * 16 + fr;
                const float r = rstd_from_part(part, row, fq) * cs;
#pragma unroll
                for (int bj = 0; bj < 2; ++bj) {
                    const f32x4 a = acc[ai][bj][m][0] * r, b = acc[ai][bj][m][1] * r;
                    u32x4 w; w.x = cvt_pk_bf16(a[0], a[1]); w.y = cvt_pk_bf16(a[2], a[3]); w.z = cvt_pk_bf16(b[0], b[1]); w.w = cvt_pk_bf16(b[2], b[3]);
                    *GASP(u32x4, base + (size_t)row * D + col0 + bj * HALF) = w;
                    if (kmax) { float ss = (a[0] * a[0] + a[1] * a[1]) + (a[2] * a[2] + a[3] * a[3]) + (b[0] * b[0] + b[1] * b[1]) + (b[2] * b[2] + b[3] * b[3]);
                        ss += __shfl_xor(ss, 16); ss += __shfl_xor(ss, 32); km[bj] = fmaxf(km[bj], ss); }
                }
                asm volatile("" ::: "memory");
            }
        if (kmax && u.pn < 4) {
#pragma unroll
            for (int bj = 0; bj < 2; ++bj) {
                float v = km[bj];
#pragma unroll
                for (int o = 1; o < 16; o <<= 1) v = fmaxf(v, __shfl_xor(v, o));
                v *= 1.02f;
                if (ln_ == 0) { const int b = (u.pm * BM) / SEQ, head = (u.pn & 3) * 4 + 2 * bj + (wc >> 1); atomicMax(kmax + (b * NH + head) * 2 + (wc & 1), __float_as_uint(v)); }
            }
        }
    }
};
template <int CTRL> __device__ __forceinline__ float dpp_mov(float old, float src) {
    return __builtin_bit_cast(float, __builtin_amdgcn_update_dpp(__builtin_bit_cast(int, old), __builtin_bit_cast(int, src), CTRL, 0xf, 0xf, false));
}
template <int CTRL> __device__ __forceinline__ float dpp_all(float src) {
    return __builtin_bit_cast(float, __builtin_amdgcn_update_dpp(0, __builtin_bit_cast(int, src), CTRL, 0xf, 0xf, true));
}
struct EpiConv {
    static constexpr bool PERM = true, AFTER_DRAIN = false;
    unsigned char* wsb; const float* cw; const float* cb; LAS unsigned char* xch; int layer;
    __device__ __forceinline__ void operator()(f32x4 (&acc)[2][2][4][2], const Unit& u, int wr, int wc, int fr_in, int fq_in) const {
        int ln_ = threadIdx.x & 63; asm volatile("" : "+v"(ln_)); const int fr = ln_ & 15, fq = ln_ >> 4; (void)fr_in; (void)fq_in;
        const int trow0 = 256 * u.pm;
        bf16_t* const act = (bf16_t*)(wsb + WS_ACT); const float* const part = (const float*)(wsb + WS_PART); float* const halo = (float*)(wsb + WS_HALO); unsigned* const flags = (unsigned*)(wsb + 16384) + layer * (128 * 22);
#pragma unroll
        for (int ai = 0; ai < 2; ++ai)
#pragma unroll
            for (int m = 0; m < 4; ++m) {
                const int R = trow0 + ai * HALF + wr * 64 + m * 16 + fr;
                const float rs = rstd_from_part(part, R, fq);
#pragma unroll
                for (int bj = 0; bj < 2; ++bj)
#pragma unroll
                    for (int n = 0; n < 2; ++n) acc[ai][bj][m][n] *= rs;
                asm volatile("" ::: "memory");
            }
        if (fr >= 14) {
#pragma unroll
            for (int ai = 0; ai < 2; ++ai) { const int q = 2 * ai + wr;
#pragma unroll
                for (int bj = 0; bj < 2; ++bj)
#pragma unroll
                    for (int n = 0; n < 2; ++n)
                        *(LAS f32x4*)(xch + (size_t)(((q * 2 + (fr - 14)) * 256 + 128 * bj + 32 * wc + 8 * fq + 4 * n) * 4)) = acc[ai][bj][3][n];
            }
            if (wr == 1) {
                float* hp = halo + ((size_t)(u.pm * 22 + u.pn) * 2 + (fr - 14)) * 256 + 32 * wc + 8 * fq;
#pragma unroll
                for (int bj = 0; bj < 2; ++bj)
#pragma unroll
                    for (int n = 0; n < 2; ++n)
#pragma unroll
                        for (int e = 0; e < 4; ++e) __hip_atomic_store(GASP(float, hp + 128 * bj + 4 * n + e), acc[1][bj][3][n][e], __ATOMIC_RELAXED, __HIP_MEMORY_SCOPE_AGENT);
            }
        }
        if (wr == 1) asm volatile("s_waitcnt vmcnt(0)" ::: "memory");
        asm volatile("s_waitcnt lgkmcnt(0)" ::: "memory"); __builtin_amdgcn_s_barrier(); asm volatile("" ::: "memory");
        const bool need = (u.pm & 15) != 0;
        if (wr == 0 && wc == 0) {
            if (fr == 0 && fq == 0) {
                __hip_atomic_store(flags + u.pm * 22 + u.pn, 1u, __ATOMIC_RELAXED, __HIP_MEMORY_SCOPE_AGENT);
                if (need) { unsigned sp = 0u; while (__hip_atomic_load(flags + (u.pm - 1) * 22 + u.pn, __ATOMIC_RELAXED, __HIP_MEMORY_SCOPE_AGENT) == 0u) { __builtin_amdgcn_s_sleep(2); if (++sp > (1u << 22)) break; } }
                __builtin_amdgcn_fence(__ATOMIC_ACQUIRE, "agent");
            }
        }
        asm volatile("s_waitcnt lgkmcnt(0)" ::: "memory"); __builtin_amdgcn_s_barrier(); asm volatile("" ::: "memory");
#pragma unroll
        for (int n = 0; n < 2; ++n) {
            int fq2 = fq, fr2 = fr; asm volatile("" : "+v"(fq2), "+v"(fr2));
            const int jc = u.pn * 128 + 32 * wc + 8 * fq2 + 4 * n;
            const f32x4 g0 = *GASP(const f32x4, cw + jc), g1 = *GASP(const f32x4, cw + FF2 + jc), g2 = *GASP(const f32x4, cw + 2 * FF2 + jc), gb = *GASP(const f32x4, cb + jc);
            const f32x4 u0 = *GASP(const f32x4, cw + FF + jc), u1 = *GASP(const f32x4, cw + FF2 + FF + jc), u2 = *GASP(const f32x4, cw + 2 * FF2 + FF + jc), ub = *GASP(const f32x4, cb + FF + jc);
#pragma unroll
            for (int ai = 0; ai < 2; ++ai) {
                const int q = 2 * ai + wr;
                f32x4 vbg = (f32x4){0.f, 0.f, 0.f, 0.f}, vbu = vbg;
                if (fr2 >= 14) {
                    if (q >= 1) {
                        vbg = *(const LAS f32x4*)(xch + (size_t)((((q - 1) * 2 + (fr2 - 14)) * 256 + 32 * wc + 8 * fq2 + 4 * n) * 4));
                        vbu = *(const LAS f32x4*)(xch + (size_t)((((q - 1) * 2 + (fr2 - 14)) * 256 + 128 + 32 * wc + 8 * fq2 + 4 * n) * 4));
                    } else if (need) {
                        const float* hp = halo + ((size_t)((u.pm - 1) * 22 + u.pn) * 2 + (fr2 - 14)) * 256 + 32 * wc + 8 * fq2 + 4 * n;
#pragma unroll
                        for (int e = 0; e < 4; ++e) { vbg[e] = __hip_atomic_load(GASP(const float, hp + e), __ATOMIC_RELAXED, __HIP_MEMORY_SCOPE_AGENT); vbu[e] = __hip_atomic_load(GASP(const float, hp + 128 + e), __ATOMIC_RELAXED, __HIP_MEMORY_SCOPE_AGENT); }
                    }
                }
#pragma unroll
                for (int m = 0; m < 4; ++m) {
                    const int R = trow0 + ai * HALF + wr * 64 + m * 16 + fr2;
                    const f32x4 cg = acc[ai][0][m][n], cu = acc[ai][1][m][n];
                    const f32x4 pg = (m == 0) ? vbg : acc[ai][0][m == 0 ? 0 : m - 1][n], pu = (m == 0) ? vbu : acc[ai][1][m == 0 ? 0 : m - 1][n];
                    float o[4];
#pragma unroll
                    for (int e = 0; e < 4; ++e) {
                        const float g1p = dpp_mov<0x111>(dpp_all<0x121>(pg[e]), cg[e]);
                        const float g2p = dpp_mov<0x112>(dpp_all<0x122>(pg[e]), cg[e]);
                        const float u1p = dpp_mov<0x111>(dpp_all<0x121>(pu[e]), cu[e]);
                        const float u2p = dpp_mov<0x112>(dpp_all<0x122>(pu[e]), cu[e]);
                        const float ug = g2[e] * cg[e] + (g1[e] * g1p + (g0[e] * g2p + gb[e]));
                        const float uu = u2[e] * cu[e] + (u1[e] * u1p + (u0[e] * u2p + ub[e]));
                        o[e] = ug * uu * __builtin_amdgcn_rcpf(1.0f + __expf(-ug));
                    }
                    u32x2 w; w.x = cvt_pk_bf16(o[0], o[1]); w.y = cvt_pk_bf16(o[2], o[3]); *GASP(u32x2, act + (size_t)R * FF + jc) = w;
                }
            }
            asm volatile("" ::: "memory");
        }
    }
};

__device__ __forceinline__ void tr_item(const float* W, int ldw, int K, bf16_t* WT, int nblk, int item, int lane, LAS float* scr, int mode, int hoff, const float* gk) {
    const int kb = item / nblk, nb = item % nblk, k0 = 64 * kb, n0 = 64 * nb;
    int sc = n0;
    if (mode == 1) { const int t = n0 >> 8, j = n0 & 255; sc = (j < 128) ? (128 * t + j) : (hoff + 128 * t + j - 128); }
    const int c4 = lane & 15, kq = lane >> 4;
#pragma unroll
    for (int i = 0; i < 16; ++i) { const int kk = 4 * i + kq; f32x4 v = *GASP(const f32x4, W + (size_t)(k0 + kk) * ldw + sc + 4 * c4); if (gk) v = v * *GASP(const float, gk + k0 + kk);
        LAS float* d = scr + kk * 65 + 4 * c4; d[0] = v[0]; d[1] = v[1]; d[2] = v[2]; d[3] = v[3]; }
    asm volatile("s_waitcnt lgkmcnt(0)" ::: "memory");
    const int c = lane & 7;
#pragma unroll
    for (int j = 0; j < 8; ++j) { const int n = (lane >> 3) + 8 * j; const LAS float* s = scr + (8 * c) * 65 + n;
        u32x4 o; o.x = pk2(s[0 * 65], s[1 * 65]); o.y = pk2(s[2 * 65], s[3 * 65]); o.z = pk2(s[4 * 65], s[5 * 65]); o.w = pk2(s[6 * 65], s[7 * 65]);
        *GASP(u32x4, WT + (size_t)(n0 + n) * K + k0 + 8 * c) = o; }
    asm volatile("s_waitcnt lgkmcnt(0)" ::: "memory");
}

struct Args { const float* in[22]; float* out; unsigned char* ws; };

__device__ __forceinline__ float gelu_tanh(float y) {
    const float z = 0.7978845608028654f * (y + 0.044715f * y * y * y);
    const float t = 1.0f - 2.0f * __builtin_amdgcn_rcpf(__expf(2.0f * z) + 1.0f);
    return 0.5f * y * (1.0f + t);
}

__device__ __forceinline__ void s5_simple(const Args& a, int l, const float* h, const float* part, bf16_t* Y, const float* LBt, const float* BBt) {
    int tid_l = threadIdx.x; asm volatile("" : "+v"(tid_l)); const int tid = tid_l, lane = tid & 63, wave = tid >> 6;
    if (wave >= 2) return;
    for (int item = blockIdx.x * 2 + wave; item < NBATCH * NG; item += gridDim.x * 2) {
        const int b = item / NG, g = item % NG, p = lane;
        const float lbre = LBt[((l * NG + g) * NP + p) * 2], lbim = LBt[((l * NG + g) * NP + p) * 2 + 1];
        float bbre[16], bbim[16], cre[16], cim[16], gm[16], dsk[16];
        const float* bbt = BBt + ((size_t)(l * NG + g) * NP + p) * 32;
#pragma unroll
        for (int hh = 0; hh < 16; ++hh) {
            bbre[hh] = bbt[hh]; bbim[hh] = bbt[16 + hh];
            cre[hh] = a.in[8][((size_t)(l * NG + g) * 16 + hh) * NP + p]; cim[hh] = a.in[9][((size_t)(l * NG + g) * 16 + hh) * NP + p];
            gm[hh] = a.in[1][l * D + 16 * g + hh]; dsk[hh] = a.in[10][l * D + 16 * g + hh];
        }
        float sre = 0.f, sim = 0.f;
        const size_t row0 = (size_t)b * SEQ;
        for (int t = 0; t < SEQ; ++t) {
            const f32x4* hp = (const f32x4*)(h + (row0 + t) * D + 16 * g);
            const f32x4 cv[4] = {hp[0], hp[1], hp[2], hp[3]}; const float cp = (lane < 32) ? part[(row0 + t) * 32 + lane] : 0.f;
            const float rstd = rsqrtf(wave_sum(cp) * (1.0f / D) + EPS);
            float uu[16];
#pragma unroll
            for (int hh = 0; hh < 16; ++hh) uu[hh] = cv[hh >> 2][hh & 3] * rstd * gm[hh];
            float bure = 0.f, buim = 0.f;
#pragma unroll
            for (int hh = 0; hh < 16; ++hh) { bure += bbre[hh] * uu[hh]; buim += bbim[hh] * uu[hh]; }
            const float nre = lbre * sre - lbim * sim + bure, nim = lbre * sim + lbim * sre + buim;
            sre = nre; sim = nim;
            float my = 0.f;
#pragma unroll
            for (int hh = 0; hh < 16; ++hh) {
                float v = cre[hh] * sre - cim[hh] * sim;
                v = wave_sum(v) + dsk[hh] * uu[hh];
                my = (lane == hh) ? v : my;
            }
            if (lane < 16) Y[(row0 + t) * D + 16 * g + lane] = (bf16_t)f2bf(gelu_tanh(my));
        }
    }
}


typedef short s16x8 __attribute__((ext_vector_type(8)));
typedef float f32x16 __attribute__((ext_vector_type(16)));
typedef float f32x2 __attribute__((ext_vector_type(2)));
__device__ __forceinline__ void lpow(double lr, double li, double dt, int n, double& re, double& im) {
    const double mag = exp(lr * dt * (double)n), ang = li * dt * (double)n; re = mag * cos(ang); im = mag * sin(ang);
}
__device__ __forceinline__ void cpowf(float br, float bi, int n, float& rr, float& ri) {
    float xr = br, xi = bi; rr = 1.f; ri = 0.f;
#pragma unroll 1
    while (n) { if (n & 1) { const float t = rr * xr - ri * xi; ri = rr * xi + ri * xr; rr = t; } const float t2 = xr * xr - xi * xi; xi = 2.f * xr * xi; xr = t2; n >>= 1; }
}
constexpr int S5_U = 0, S5_USTR = 1040, S5_K = 66560, S5_S = S5_K + 16384, S5_SSTR = 272, S5_L = S5_S + 64 * S5_SSTR, S5_LSTR = 528, S5_R = S5_L + 64 * S5_LSTR, S5_LDS_END = S5_R + 8192;
static_assert(S5_LDS_END <= LDS_BYTES, "S5 LDS map");
__device__ __forceinline__ void s5_mfma(const Args& a, int l, const float* h, const bf16_t* hbf, const float* part, bf16_t* Y, const unsigned char* ws, LAS unsigned char* lds) {
    int tid_l = threadIdx.x; asm volatile("" : "+v"(tid_l)); const int tid = tid_l, lane = tid & 63, wave = __builtin_amdgcn_readfirstlane(tid >> 6);
    const int n32 = lane & 31, kh = lane >> 5, qd = tid & 3;
    for (int item = blockIdx.x; item < NBATCH * NG; item += gridDim.x) {
        int g = item & 63, b = item >> 6;
        if (gridDim.x == 256) { const int c = blockIdx.x, x = c & 7, idx = c >> 3; g = 8 * x + (idx & 7); b = (idx >> 3) + 4 * (item >> 8); }
        const int lg = l * NG + g;
        const __attribute__((address_space(1))) s16x8* Wt = GASP(const s16x8, ws + WS_S5W) + (size_t)lg * (4 * 32 * 64);
        const __attribute__((address_space(1))) s16x8* Vt = GASP(const s16x8, ws + WS_S5V) + (size_t)lg * (16 * 8 * 64);
        const f32x4 gm = *GASP(const f32x4, a.in[1] + l * D + 16 * g + 4 * qd);
        float sre = 0.f, sim = 0.f, a32r = 0.f, a32i = 0.f;
        if (tid < 64) { const float* ap = (const float*)(ws + WS_S5A) + (size_t)(lg * 64 + tid) * 2; a32r = ap[0]; a32i = ap[1]; }
        for (int sg = 0; sg < 2; ++sg) {
            const size_t row0 = (size_t)b * SEQ + sg * 2048;
            __syncthreads();
            if (sg == 0) {
                const __attribute__((address_space(1))) u32x4* kp = GASP(const u32x4, ws + WS_S5K) + (size_t)lg * 1024;
                *(LAS u32x4*)(lds + S5_K + tid * 16) = kp[tid]; *(LAS u32x4*)(lds + S5_K + 8192 + tid * 16) = kp[512 + tid];
            }
#pragma unroll 8
            for (int i = 0; i < 16; ++i) {
                const int idx = tid + 512 * i, tt = idx >> 2;
                f32x4 v;
                if (h) v = *GASP(const f32x4, h + (row0 + tt) * D + 16 * g + 4 * qd);
                else { const u32x2 hw = *GASP(const u32x2, hbf + (row0 + tt) * D + 16 * g + 4 * qd);
                    v[0] = __builtin_bit_cast(float, hw.x << 16); v[1] = __builtin_bit_cast(float, hw.x & 0xffff0000u); v[2] = __builtin_bit_cast(float, hw.y << 16); v[3] = __builtin_bit_cast(float, hw.y & 0xffff0000u); }
                const f32x4 p0 = *GASP(const f32x4, part + (row0 + tt) * 32 + 8 * qd), p1 = *GASP(const f32x4, part + (row0 + tt) * 32 + 8 * qd + 4);
                float sm = ((p0[0] + p0[1]) + (p0[2] + p0[3])) + ((p1[0] + p1[1]) + (p1[2] + p1[3]));
                sm += __shfl_xor(sm, 1); sm += __shfl_xor(sm, 2);
                const float r = rsqrtf(sm * (1.0f / D) + EPS);
                u32x2 w; w.x = cvt_pk_bf16(v[0] * r * gm[0], v[1] * r * gm[1]); w.y = cvt_pk_bf16(v[2] * r * gm[2], v[3] * r * gm[3]);
                *(LAS u32x2*)(lds + S5_U + (tt >> 5) * S5_USTR + (tt & 31) * 32 + qd * 8) = w;
            }
            __syncthreads();
            {
                const int mt = wave >> 1, nt = wave & 1;
                f32x16 acc = {}, accb = {};
                const __attribute__((address_space(1))) s16x8* wp = Wt + (size_t)(mt * 32) * 64 + lane;
                const LAS unsigned char* up = lds + S5_U + (32 * nt + n32) * S5_USTR + kh * 16;
#pragma unroll 8
                for (int j = 0; j < 32; j += 2) {
                    const s16x8 A0 = wp[j * 64], B0 = *(const LAS s16x8*)(up + j * 32), A1 = wp[(j + 1) * 64], B1 = *(const LAS s16x8*)(up + (j + 1) * 32);
                    acc = __builtin_amdgcn_mfma_f32_32x32x16_bf16(A0, B0, acc, 0, 0, 0);
                    accb = __builtin_amdgcn_mfma_f32_32x32x16_bf16(A1, B1, accb, 0, 0, 0);
                }
                acc += accb;
#pragma unroll
                for (int q4 = 0; q4 < 4; ++q4)
                    *(LAS f32x4*)(lds + S5_L + (32 * nt + n32) * S5_LSTR + (32 * mt + 8 * q4 + 4 * kh) * 4) = (f32x4){acc[4 * q4], acc[4 * q4 + 1], acc[4 * q4 + 2], acc[4 * q4 + 3]};
            }
            __syncthreads();
            if (tid < 64) {
#pragma unroll 1
                for (int c0 = 0; c0 < 64; c0 += 32) {
                    f32x2 lv[32];
#pragma unroll
                    for (int c = 0; c < 32; ++c) lv[c] = *(const LAS f32x2*)(lds + S5_L + (c0 + c) * S5_LSTR + tid * 8);
#pragma unroll
                    for (int c = 0; c < 32; ++c) {
                        *(LAS unsigned*)(lds + S5_S + (c0 + c) * S5_SSTR + tid * 4) = cvt_pk_bf16(sre, sim);
                        const float nr = a32r * sre - a32i * sim + lv[c][0], ni = a32r * sim + a32i * sre + lv[c][1];
                        sre = nr; sim = ni;
                    }
                }
            }
            __syncthreads();
            {
                const int nt = wave & 1, dtl = n32 >> 4, hp = n32 & 15;
                const LAS unsigned char* up = lds + S5_U + (32 * nt + n32) * S5_USTR + kh * 16;
                const LAS unsigned char* sp = lds + S5_S + (32 * nt + n32) * S5_SSTR + kh * 16;
                const LAS unsigned char* kp = lds + S5_K + hp * 32 + kh * 16;
                const int w4 = wave >> 1;
                f32x16 acc4[4] = {};
#pragma unroll 4
                for (int ks = 0; ks < 8; ++ks) {
                    const s16x8 B = *(const LAS s16x8*)(sp + ks * 32);
#pragma unroll
                    for (int i4 = 0; i4 < 4; ++i4) {
                        const s16x8 A = *(Vt + (size_t)((w4 + 4 * i4) * 8 + ks) * 64 + lane);
                        acc4[i4] = __builtin_amdgcn_mfma_f32_32x32x16_bf16(A, B, acc4[i4], 0, 0, 0);
                    }
                }
                for (int j = 0; j <= 2 * (w4 + 12) + 1; ++j) {
                    const s16x8 B = *(const LAS s16x8*)(up + j * 32);
#pragma unroll
                    for (int i4 = 0; i4 < 4; ++i4) {
                        const int mt = w4 + 4 * i4;
                        if (j <= 2 * mt + 1) {
                            const int lag = 2 * mt + dtl - j, lagc = lag < 0 ? 0 : lag;
                            s16x8 A = *(const LAS s16x8*)(kp + lagc * 512);
                            if (lag < 0) A = (s16x8){0, 0, 0, 0, 0, 0, 0, 0};
                            acc4[i4] = __builtin_amdgcn_mfma_f32_32x32x16_bf16(A, B, acc4[i4], 0, 0, 0);
                        }
                    }
                }
#pragma unroll
                for (int i4 = 0; i4 < 4; ++i4) {
                    const int mt = w4 + 4 * i4;
#pragma unroll
                    for (int q4 = 0; q4 < 4; ++q4) {
                        const int tok = (32 * nt + n32) * 32 + 2 * mt + (q4 >> 1), h0 = 8 * (q4 & 1) + 4 * kh;
                        u32x2 w; w.x = cvt_pk_bf16(gelu_tanh(acc4[i4][4 * q4]), gelu_tanh(acc4[i4][4 * q4 + 1])); w.y = cvt_pk_bf16(gelu_tanh(acc4[i4][4 * q4 + 2]), gelu_tanh(acc4[i4][4 * q4 + 3]));
                        *GASP(u32x2, Y + (row0 + tok) * D + 16 * g + h0) = w;
                    }
                }
            }
        }
    }
    __syncthreads();
}

__device__ __forceinline__ void f_phase(const Args& a, const float* h, const float* part, const float* WF, float* LC, float* TOT, LAS unsigned char* lds) {
    int tid_l = threadIdx.x; asm volatile("" : "+v"(tid_l)); const int tid = tid_l, lane = tid & 63, wave = tid >> 6;
    LAS float* ls = (LAS float*)lds;
    for (int item = blockIdx.x; item < M / 256; item += gridDim.x) {
        __syncthreads();
        const int b = item / 16, ch = item % 16;
        for (int tl = wave * 32; tl < wave * 32 + 32; ++tl) {
            const size_t row = (size_t)item * 256 + tl;
            float accv[16];
#pragma unroll
            for (int hh = 0; hh < 16; ++hh) accv[hh] = 0.f;
#pragma unroll 2
            for (int kk = 0; kk < 16; ++kk) {
                const int k = kk * 64 + lane; const float hv = h[row * D + k];
                const f32x4* wp = (const f32x4*)(WF + (size_t)k * 16);
                const f32x4 w0 = wp[0], w1 = wp[1], w2 = wp[2], w3 = wp[3];
#pragma unroll
                for (int e = 0; e < 4; ++e) { accv[e] += hv * w0[e]; accv[4 + e] += hv * w1[e]; accv[8 + e] += hv * w2[e]; accv[12 + e] += hv * w3[e]; }
            }
            const float rstd = rstd_row_wave(part, (int)row, lane);
            float mine = 0.f;
#pragma unroll
            for (int hh = 0; hh < 16; ++hh) { const float v = wave_sum(accv[hh]); mine = (lane == hh) ? v : mine; }
            if (lane < 16) {
                const float x = mine * rstd + a.in[14][lane];
                const float lsg = fminf(x, 0.f) - log1pf(__expf(-fabsf(x)));
                ls[tl * 16 + lane] = lsg;
            }
        }
        __syncthreads();
        if (tid < 16) {
            float c = 0.f; float* lc = LC + ((size_t)(b * NH + tid)) * SEQ + ch * 256;
            for (int t = 0; t < 256; ++t) { c += ls[t * 16 + tid]; lc[t] = c; }
            TOT[(b * NH + tid) * 16 + ch] = c;
        }
    }
    __syncthreads();
}


__device__ __forceinline__ void f_phase2(const Args& a, const bf16_t* HB, const float* part, const bf16_t* WFb, float* LC, float* TOT, LAS unsigned char* lds) {
    int tid_l = threadIdx.x; asm volatile("" : "+v"(tid_l)); const int tid = tid_l, lane = tid & 63, wave = __builtin_amdgcn_readfirstlane(tid >> 6);
    const int n32 = lane & 31, kh = lane >> 5;
    LAS float* ls = (LAS float*)lds;
    LAS float* rs = ls + 128 * 16;
    LAS float* seg = rs + 128;
    for (int item = blockIdx.x; item < M / 128; item += gridDim.x) {
        __syncthreads();
        const int b = item >> 5, ch = item & 31; const size_t row0 = (size_t)item * 128;
#pragma unroll
        for (int i = 0; i < 2; ++i) {
            const int idx = tid + 512 * i, r = idx >> 3, p8 = idx & 7;
            const f32x4 v = *(const f32x4*)(part + (row0 + r) * 32 + 4 * p8);
            float sm = (v[0] + v[1]) + (v[2] + v[3]);
            sm += __shfl_xor(sm, 1); sm += __shfl_xor(sm, 2); sm += __shfl_xor(sm, 4);
            if (p8 == 0) rs[r] = rsqrtf(sm * (1.0f / D) + EPS);
        }
        f32x16 acc = {};
        if (wave < 4) {
            const __attribute__((address_space(1))) s16x8* ap = GASP(const s16x8, HB + (row0 + 32 * wave + n32) * D + kh * 8);
            const __attribute__((address_space(1))) s16x8* bp = GASP(const s16x8, WFb + (size_t)n32 * D + kh * 8);
#pragma unroll 16
            for (int ks = 0; ks < 64; ++ks) acc = __builtin_amdgcn_mfma_f32_32x32x16_bf16(ap[ks * 2], bp[ks * 2], acc, 0, 0, 0);
        }
        __syncthreads();
        if (wave < 4 && n32 < 16) {
            const float bf = a.in[14][n32];
#pragma unroll
            for (int i = 0; i < 16; ++i) {
                const int tl = 32 * wave + (i & 3) + 8 * (i >> 2) + 4 * kh;
                const float x = acc[i] * rs[tl] + bf;
                ls[tl * 16 + n32] = fminf(x, 0.f) - log1pf(__expf(-fabsf(x)));
            }
        }
        __syncthreads();
        const int hd = tid & 15, sgm = tid >> 4;
        float v4[4], sm = 0.f;
#pragma unroll
        for (int e = 0; e < 4; ++e) { v4[e] = ls[(4 * sgm + e) * 16 + hd]; sm += v4[e]; }
        seg[sgm * 16 + hd] = sm;
        __syncthreads();
        float c = 0.f;
#pragma unroll
        for (int s2 = 0; s2 < 32; ++s2) { const float t = seg[s2 * 16 + hd]; c += (s2 < sgm) ? t : 0.f; }
        float* lc = LC + ((size_t)(b * NH + hd)) * SEQ + ch * 128 + 4 * sgm;
        f32x4 o0;
        c += v4[0]; o0[0] = c; c += v4[1]; o0[1] = c; c += v4[2]; o0[2] = c; c += v4[3]; o0[3] = c;
        *GASP(f32x4, lc) = o0;
        if (sgm == 31) *GASP(float, TOT + (b * NH + hd) * 32 + ch) = c;
    }
    __syncthreads();
}

__device__ __forceinline__ void attn_simple(const bf16_t* Q, const bf16_t* K, const bf16_t* V, bf16_t* O, const float* LC, const float* TOT, LAS unsigned char* lds) {
    int tid_l = threadIdx.x; asm volatile("" : "+v"(tid_l)); const int tid = tid_l;
    LAS float* Kt = (LAS float*)lds;
    LAS float* Vt = Kt + 64 * 64;
    LAS float* bias = Vt + 64 * 64;
    LAS float* offs = bias + 64;
    const int nunits = NBATCH * NH * 8;
    for (int ui = blockIdx.x; ui < nunits; ui += gridDim.x) {
        const int slot = ui / gridDim.x;
        int bh, qb;
        if (gridDim.x == 256) { const int v = blockIdx.x; bh = v >> 1; const int half = v & 1, s = slot & 3; qb = (s & 1) ? (8 - s - half) : (s + half); }
        else { bh = ui >> 3; qb = ui & 7; }
        const int b = bh / NH, hd = bh % NH;
        const int i = qb * 512 + tid;
        __syncthreads();
        if (tid == 0) { float c = 0.f; for (int cc = 0; cc < 16; ++cc) { offs[cc] = c; c += TOT[bh * 16 + cc]; } }
        float q[64], o[64];
        {
            const u32x4* qp = (const u32x4*)(Q + ((size_t)b * SEQ + i) * D + hd * HD);
#pragma unroll
            for (int c8 = 0; c8 < 8; ++c8) { const u32x4 w = qp[c8];
#pragma unroll
                for (int e = 0; e < 4; ++e) { q[c8 * 8 + 2 * e] = __builtin_bit_cast(float, w[e] << 16); q[c8 * 8 + 2 * e + 1] = __builtin_bit_cast(float, w[e] & 0xffff0000u); } }
        }
#pragma unroll
        for (int d = 0; d < 64; ++d) o[d] = 0.f;
        float mx = -1e30f, lsum = 0.f;
        const int ntiles = (qb * 512 + 512) / 64;
        for (int jt = 0; jt < ntiles; ++jt) {
            __syncthreads();
            {
                const int r = tid >> 3, c8 = tid & 7; const size_t src = ((size_t)b * SEQ + jt * 64 + r) * D + hd * HD + c8 * 8;
                const u32x4 kw = *(const u32x4*)(K + src), vw = *(const u32x4*)(V + src);
#pragma unroll
                for (int e = 0; e < 4; ++e) {
                    Kt[r * 64 + c8 * 8 + 2 * e] = __builtin_bit_cast(float, kw[e] << 16); Kt[r * 64 + c8 * 8 + 2 * e + 1] = __builtin_bit_cast(float, kw[e] & 0xffff0000u);
                    Vt[r * 64 + c8 * 8 + 2 * e] = __builtin_bit_cast(float, vw[e] << 16); Vt[r * 64 + c8 * 8 + 2 * e + 1] = __builtin_bit_cast(float, vw[e] & 0xffff0000u);
                }
                if (tid < 64) bias[tid] = -(LC[(size_t)bh * SEQ + jt * 64 + tid] + offs[(jt * 64) >> 8]) * LOG2E;
            }
            __syncthreads();
            int jmax = i - jt * 64; jmax = jmax > 63 ? 63 : jmax;
            for (int j = 0; j <= jmax; ++j) {
                float s = bias[j];
                const LAS f32x4* kr = (const LAS f32x4*)(Kt + j * 64);
#pragma unroll
                for (int d4 = 0; d4 < 16; ++d4) { const f32x4 kv = kr[d4]; s += q[4 * d4] * kv[0] + q[4 * d4 + 1] * kv[1] + q[4 * d4 + 2] * kv[2] + q[4 * d4 + 3] * kv[3]; }
                const float mn = fmaxf(mx, s), corr = exp2f(mx - mn), pp = exp2f(s - mn);
                lsum = lsum * corr + pp; mx = mn;
                const LAS f32x4* vr = (const LAS f32x4*)(Vt + j * 64);
#pragma unroll
                for (int d4 = 0; d4 < 16; ++d4) { const f32x4 vv = vr[d4];
                    o[4 * d4] = o[4 * d4] * corr + pp * vv[0]; o[4 * d4 + 1] = o[4 * d4 + 1] * corr + pp * vv[1]; o[4 * d4 + 2] = o[4 * d4 + 2] * corr + pp * vv[2]; o[4 * d4 + 3] = o[4 * d4 + 3] * corr + pp * vv[3]; }
            }
        }
        const float inv = 1.0f / lsum;
        u32x4* op = (u32x4*)(O + ((size_t)b * SEQ + i) * D + hd * HD);
#pragma unroll
        for (int c8 = 0; c8 < 8; ++c8) { u32x4 w;
#pragma unroll
            for (int e = 0; e < 4; ++e) w[e] = pk2(o[c8 * 8 + 2 * e] * inv, o[c8 * 8 + 2 * e + 1] * inv);
            op[c8] = w; }
    }
    __syncthreads();
}

#define XB_TMO      128
#define XB_XCNT(j)  (256  + 64 * (j))
#define XB_XSUB(j)  (1280 + 64 * (j))
#define XB_XGEN(j)  (2304 + 64 * (j))
#define XB_TOP      3328
#define XB_TOPGEN   3392
#define XCD_BAR_WORDS 3456
#define XB_SPIN_CAP (1u << 18)

__device__ __forceinline__ unsigned xb_ld(unsigned* p)              { return __hip_atomic_load(p, __ATOMIC_RELAXED, __HIP_MEMORY_SCOPE_AGENT); }
__device__ __forceinline__ unsigned xb_add(unsigned* p, unsigned v) { return __hip_atomic_fetch_add(p, v, __ATOMIC_RELAXED, __HIP_MEMORY_SCOPE_AGENT); }
__device__ __forceinline__ unsigned xb_xcc_id() { return (unsigned)__builtin_amdgcn_s_getreg((3 << 11) | 20) & 0xFu; }
#define XB_SPIN(cond, bar) do { unsigned _sp = 0; while (cond) { __builtin_amdgcn_s_sleep(1); \
    if ((++_sp & 255u) == 0u) { if (xb_ld(&(bar)[XB_TMO])) break; if (_sp > XB_SPIN_CAP) { atomicAdd(&(bar)[XB_TMO], 1u); break; } } } } while (0)

struct XcdBarrier {
    unsigned* bar; unsigned x;
    volatile LAS unsigned* st;
};

__device__ __forceinline__ XcdBarrier xcd_barrier_post(unsigned* bar, volatile LAS unsigned* st) {
    XcdBarrier b; b.bar = bar; b.x = xb_xcc_id(); b.st = st;
    if (threadIdx.x == 0) (void)xb_add(&bar[XB_XCNT(b.x)], 1u);
    return b;
}
__device__ __forceinline__ void xcd_barrier_complete(unsigned* bar, unsigned x, unsigned& nloc, unsigned& nx) {
    const unsigned G = gridDim.x * gridDim.y * gridDim.z;
    unsigned sum, cnt, mine, sp = 0u;
    for (;;) {
        sum = 0u; cnt = 0u; mine = 0u;
#pragma unroll
        for (unsigned j = 0; j < 16; ++j) { const unsigned c = xb_ld(&bar[XB_XCNT(j)]); sum += c; cnt += (c > 0u) ? 1u : 0u; mine = (j == x) ? c : mine; }
        if (sum == G) break;
        __builtin_amdgcn_s_sleep(1);
        if ((++sp & 255u) == 0u) { if (xb_ld(&bar[XB_TMO])) break; if (sp > XB_SPIN_CAP) { atomicAdd(&bar[XB_TMO], 1u); break; } }
    }
    nloc = mine > 0u ? mine : 1u; nx = cnt > 0u ? cnt : 1u;
}

__device__ __forceinline__ void xcd_barrier(const XcdBarrier& b) {
    asm volatile("s_waitcnt vmcnt(0)" ::: "memory");
    __syncthreads();
    if (threadIdx.x == 0) {
        unsigned* bar = b.bar;
        __builtin_amdgcn_s_waitcnt(0);
        unsigned nloc = b.st[0], nx = b.st[1];
        if (nloc == 0u) { xcd_barrier_complete(bar, b.x, nloc, nx); b.st[0] = nloc; b.st[1] = nx; }
        const unsigned old = xb_add(&bar[XB_XSUB(b.x)], 1u);
        const unsigned gen = old / nloc;
        if (old + 1u == (gen + 1u) * nloc) {
            __builtin_amdgcn_fence(__ATOMIC_RELEASE, "agent");
            asm volatile("s_waitcnt vmcnt(0)" ::: "memory");
            const unsigned og = xb_add(&bar[XB_TOP], 1u);
            const unsigned tg = og / nx;
            if (og + 1u == (tg + 1u) * nx) xb_add(&bar[XB_TOPGEN], 1u);
            else XB_SPIN(xb_ld(&bar[XB_TOPGEN]) == tg, bar);
            __builtin_amdgcn_fence(__ATOMIC_ACQUIRE, "agent");
            xb_add(&bar[XB_XGEN(b.x)], 1u);
            asm volatile("s_waitcnt vmcnt(0)" ::: "memory");
        } else {
            XB_SPIN(xb_ld(&bar[XB_XGEN(b.x)]) == gen, bar);
            __builtin_amdgcn_fence(__ATOMIC_ACQUIRE, "agent");
            asm volatile("s_waitcnt vmcnt(0)" ::: "memory");
        }
    }
    __syncthreads();
}

__global__ void __launch_bounds__(512, 2) yoco_fwd(Args a) {
    extern __shared__ __attribute__((aligned(16))) unsigned char lds_raw[];
    LAS unsigned char* lds = (LAS unsigned char*)lds_raw;
    cg::grid_group grid = cg::this_grid();
    volatile LAS unsigned* bst = (volatile LAS unsigned*)(lds + (LDS_BYTES - 64));
    if (threadIdx.x == 0) { bst[0] = 0u; bst[1] = 0u; }
    __syncthreads();
    const XcdBarrier xbar = xcd_barrier_post((unsigned*)a.ws, bst);
#ifndef REP_PRO
#define REP_PRO 1
#endif
#ifndef REP_S5
#define REP_S5 1
#endif
#ifndef REP_FI
#define REP_FI 1
#endif
#ifndef REP_AT
#define REP_AT 1
#endif
#ifndef REP_KV
#define REP_KV 1
#endif
#ifndef REP_FOX
#define REP_FOX 0
#endif
#ifndef REP_ANB
#define REP_ANB 0
#endif
#ifndef REP_SYNC
#define REP_SYNC 1
#endif
#define GSYNC() do { for (int rs_ = 0; rs_ < REP_SYNC; ++rs_) xcd_barrier(xbar); } while (0)
#define PHASE_BEGIN unsigned char* ws = a.ws; asm volatile("" : "+s"(ws)); const int G = gridDim.x; (void)G;
#define WSP(T, off) ((T*)(ws + (off)))
#ifndef SK_PRO
    for (int rep_ = 0; rep_ < REP_PRO; ++rep_) {
        PHASE_BEGIN
        int tid_l = threadIdx.x; asm volatile("" : "+v"(tid_l)); const int tid = tid_l, lane = tid & 63, wave = __builtin_amdgcn_readfirstlane(tid >> 6);
        const int gw = blockIdx.x * 8 + wave, NGW = G * 8;
        LAS float* scr = (LAS float*)(lds + wave * 16640);
        constexpr int I_GLU = 16 * 32, I_FI = 16 * 88, I_FO = 44 * 16, I_KV = 16 * 32, I_SQ = 16 * 16;
        constexpr int NITEMS = 2 * I_GLU + 4 * I_FI + 4 * I_FO + I_KV + 4 * I_SQ;
        for (int it = gw; it < NITEMS; it += NGW) {
            int r = it;
            if (r < 2 * I_GLU) { const int l = r / I_GLU; tr_item(a.in[11] + (size_t)l * D * 2048, 2048, D, WSP(bf16_t, WS_WGLU) + (size_t)l * 2048 * D, 32, r % I_GLU, lane, scr, 1, 1024, nullptr); continue; } r -= 2 * I_GLU;
            if (r < 4 * I_FI) { const int l = r / I_FI; bf16_t* dst = (l < 2) ? WSP(bf16_t, WS_WFI01) + (size_t)l * FF2 * D : WSP(bf16_t, WS_WFI23) + (size_t)(l - 2) * FF2 * D;
                tr_item(a.in[17] + (size_t)l * D * FF2, FF2, D, dst, 88, r % I_FI, lane, scr, 1, FF, a.in[2] + l * D); continue; } r -= 4 * I_FI;
            if (r < 4 * I_FO) { const int l = r / I_FO; bf16_t* dst = (l < 2) ? WSP(bf16_t, WS_WFO01) + (size_t)l * D * FF : WSP(bf16_t, WS_WFO23) + (size_t)(l - 2) * D * FF;
                tr_item(a.in[20] + (size_t)l * FF * D, D, FF, dst, 16, r % I_FO, lane, scr, 0, 0, nullptr); continue; } r -= 4 * I_FO;
            if (r < I_KV) { tr_item(a.in[13], 2064, D, WSP(bf16_t, WS_WKV), 32, r, lane, scr, 0, 0, a.in[12]); continue; } r -= I_KV;
            if (r < 2 * I_SQ) { const int j = r / I_SQ; tr_item(a.in[15] + (size_t)j * D * D, D, D, WSP(bf16_t, WS_WQ) + (size_t)j * D * D, 16, r % I_SQ, lane, scr, 0, 0, a.in[1] + (2 + j) * D); continue; } r -= 2 * I_SQ;
            { const int j = r / I_SQ; tr_item(a.in[16] + (size_t)j * D * D, D, D, WSP(bf16_t, WS_WO) + (size_t)j * D * D, 16, r % I_SQ, lane, scr, 0, 0, nullptr); }
        }
        for (int i = blockIdx.x * 512 + tid; i < 32 * D; i += G * 512) { const int hh = i >> 10, k = i & 1023; WSP(bf16_t, WS_WF)[i] = (bf16_t)f2bf(hh < 16 ? a.in[12][k] * a.in[13][(size_t)k * 2064 + 2048 + hh] : 0.f); }
        for (int i = blockIdx.x * 512 + tid; i < 2 * NG * NP; i += G * 512) {
            const int lg = i / NP;
            const double lr = a.in[3][i], li = a.in[4][i], dt = exp((double)a.in[5][lg]);
            double l1r, l1i; lpow(lr, li, dt, 1, l1r, l1i);
            const double den = lr * lr + li * li, nr = l1r - 1.0;
            double* dp = WSP(double, WS_S5D) + (size_t)i * 4;
            dp[0] = l1r; dp[1] = l1i; dp[2] = (nr * lr + l1i * li) / den; dp[3] = (l1i * lr - nr * li) / den;
            double pr, pim; lpow(lr, li, dt, 32, pr, pim); float* ap = WSP(float, WS_S5A) + (size_t)i * 2; ap[0] = (float)pr; ap[1] = (float)pim;
        }
        const float* x = a.in[0]; float* part = WSP(float, WS_PART);
        for (int m = gw; m < M; m += NGW) {
            const __attribute__((address_space(1))) f32x4* xr = GASP(const f32x4, x + (size_t)m * D) + lane; float s = 0.f;
#pragma unroll
            for (int j = 0; j < 4; ++j) { const f32x4 v = xr[64 * j]; s += (v[0] * v[0] + v[1] * v[1]) + (v[2] * v[2] + v[3] * v[3]); }
            s = wave_sum(s);
            if (lane < 32) *GASP(float, part + (size_t)m * 32 + lane) = (lane == 0) ? s : 0.f;
        }
    }
#endif
    grid.sync();
#ifndef SK_PRO
    for (int rep_ = 0; rep_ < REP_PRO; ++rep_) {
        PHASE_BEGIN
        int tid_l = threadIdx.x; asm volatile("" : "+v"(tid_l)); const int tid = tid_l;
        const double* dtab = WSP(double, WS_S5D);
        for (int idx = blockIdx.x * 512 + tid; idx < 2 * 1048576; idx += G * 512) {
            float o8[8];
            if (idx < 1048576) {
                const int ln = idx & 63, j = (idx >> 6) & 31, mt = (idx >> 11) & 3, lg = idx >> 13;
                const int p = 16 * mt + ((ln & 31) >> 1), ri = ln & 1, kh = ln >> 5, pi = lg * 64 + p;
                const double* dp = dtab + (size_t)pi * 4;
                float pr, pim; cpowf((float)dp[0], (float)dp[1], 31 - j, pr, pim);
                const float fr = (float)dp[2], fi = (float)dp[3], gr = pr * fr - pim * fi, gi = pr * fi + pim * fr;
                const f32x4 b0 = *(const f32x4*)(a.in[6] + (size_t)pi * 16 + 8 * kh), b1 = *(const f32x4*)(a.in[6] + (size_t)pi * 16 + 8 * kh + 4);
                const f32x4 c0 = *(const f32x4*)(a.in[7] + (size_t)pi * 16 + 8 * kh), c1 = *(const f32x4*)(a.in[7] + (size_t)pi * 16 + 8 * kh + 4);
#pragma unroll
                for (int e = 0; e < 8; ++e) { const float br = e < 4 ? b0[e & 3] : b1[e & 3], bi = e < 4 ? c0[e & 3] : c1[e & 3]; o8[e] = ri ? (gr * bi + gi * br) : (gr * br - gi * bi); }
            } else {
                const int id2 = idx - 1048576, ln = id2 & 63, ks = (id2 >> 6) & 7, mt = (id2 >> 9) & 15, lg = id2 >> 13;
                const int tl = 2 * mt + ((ln & 31) >> 4), hp = ln & 15, kh = ln >> 5;
                const f32x4 cr4 = *(const f32x4*)(a.in[8] + (size_t)(lg * 16 + hp) * 64 + 8 * ks + 4 * kh), ci4 = *(const f32x4*)(a.in[9] + (size_t)(lg * 16 + hp) * 64 + 8 * ks + 4 * kh);
#pragma unroll
                for (int e2 = 0; e2 < 4; ++e2) {
                    const int pi = lg * 64 + 8 * ks + 4 * kh + e2; const double* dp = dtab + (size_t)pi * 4;
                    float pr, pim; cpowf((float)dp[0], (float)dp[1], tl + 1, pr, pim);
                    o8[2 * e2] = cr4[e2] * pr - ci4[e2] * pim; o8[2 * e2 + 1] = -(cr4[e2] * pim + ci4[e2] * pr);
                }
            }
            u32x4 w; w.x = pk2(o8[0], o8[1]); w.y = pk2(o8[2], o8[3]); w.z = pk2(o8[4], o8[5]); w.w = pk2(o8[6], o8[7]);
            if (idx < 1048576) *(GASP(u32x4, ws + WS_S5W) + idx) = w; else *(GASP(u32x4, ws + WS_S5V) + (idx - 1048576)) = w;
        }
        {
            LAS float* Pw = (LAS float*)lds; LAS float* Bb = Pw + 32 * 64 * 2; LAS float* Cc = Bb + 64 * 16 * 2;
            for (int it2 = blockIdx.x; it2 < 4 * NG; it2 += G) {
                const int lg = it2 >> 1, th = it2 & 1;
                __syncthreads();
#pragma unroll 1
                for (int i = 0; i < 4; ++i) { const int e = tid + 512 * i, tau = e >> 6, p = e & 63; const double* dp = dtab + (size_t)(lg * 64 + p) * 4; float pr, pim; cpowf((float)dp[0], (float)dp[1], tau, pr, pim); Pw[2 * e] = pr; Pw[2 * e + 1] = pim; }
#pragma unroll 1
                for (int i = 0; i < 2; ++i) { const int e = tid + 512 * i, p = e >> 4; const double* dp = dtab + (size_t)(lg * 64 + p) * 4;
                    const float fr = (float)dp[2], fi = (float)dp[3], br = a.in[6][(size_t)lg * 1024 + e], bi = a.in[7][(size_t)lg * 1024 + e];
                    Bb[2 * e] = fr * br - fi * bi; Bb[2 * e + 1] = fr * bi + fi * br;
                    Cc[2 * e] = a.in[8][(size_t)lg * 1024 + e]; Cc[2 * e + 1] = a.in[9][(size_t)lg * 1024 + e]; }
                __syncthreads();
#pragma unroll 1
                for (int i = 0; i < 8; ++i) {
                    const int o = tid + 512 * i + 4096 * th, tau = o >> 8, hp = (o >> 4) & 15, hh = o & 15; float accv = 0.f;
#pragma unroll 8
                    for (int p = 0; p < 64; ++p) {
                        const float cr = Cc[2 * (hp * 64 + p)], ci = Cc[2 * (hp * 64 + p) + 1], wr_ = Pw[2 * (tau * 64 + p)], wi_ = Pw[2 * (tau * 64 + p) + 1];
                        const float cpr = cr * wr_ - ci * wi_, cpi = cr * wi_ + ci * wr_;
                        accv += cpr * Bb[2 * (p * 16 + hh)] - cpi * Bb[2 * (p * 16 + hh) + 1];
                    }
                    if (tau == 0 && hp == hh) accv += a.in[10][(lg >> 6) * D + 16 * (lg & 63) + hp];
                    WSP(bf16_t, WS_S5K)[(size_t)lg * 8192 + o] = (bf16_t)f2bf(accv);
                }
            }
            __syncthreads();
        }
    }
#endif
    GSYNC();

    for (int l = 0; l < 4; ++l) {
        if (l < 2) {
#ifndef SK_S5
#ifdef S5_SIMPLE
            { PHASE_BEGIN s5_simple(a, l, (l == 0) ? a.in[0] : a.out, WSP(float, WS_PART), WSP(bf16_t, WS_BUFA), WSP(float, WS_S5LB), WSP(float, WS_S5BB)); }
#else
            for (int rep_ = 0; rep_ < REP_S5; ++rep_) { PHASE_BEGIN s5_mfma(a, l, (l == 0) ? a.in[0] : (const float*)nullptr, WSP(bf16_t, WS_HB), WSP(float, WS_PART), WSP(bf16_t, WS_BUFA), ws, lds); }
#endif
#endif
            GSYNC();
#ifndef SK_GLU
            {
                PHASE_BEGIN
                pg8::Gemm g{WSP(bf16_t, WS_BUFA), WSP(const bf16_t, WS_WGLU) + (size_t)l * 2048 * D, M, 2048, D, 256}; pg8::StaticOrder S; S.init(M, 2048, G, (int)blockIdx.x);
                EpiGlu E{(l == 0) ? a.in[0] : (const float*)nullptr, WSP(bf16_t, WS_HB), WSP(float, WS_PART)};
                pg8::gemm_phase<EpiGlu, pg8::StaticOrder, true, true>(lds, g, S, E);
            }
#endif
            GSYNC();
        } else {
            const int j = l - 2;
            if (l == 2) {
#ifndef SK_KV
                for (int rep_ = 0; rep_ < REP_KV; ++rep_) {
                    PHASE_BEGIN
                    pg8::Gemm g{WSP(bf16_t, WS_HB), WSP(bf16_t, WS_WKV), M, 2048, D, 256}; pg8::StaticOrder S; S.init(M, 2048, G, (int)blockIdx.x);
                    EpiScale E{WSP(bf16_t, WS_K), WSP(bf16_t, WS_V), WSP(float, WS_PART), 1.0f, WSP(unsigned, 61440)};
                    pg8::gemm_phase<EpiScale, pg8::StaticOrder, true, true>(lds, g, S, E);
                }
#endif
#ifndef SK_F
                for (int rep_ = 0; rep_ < REP_S5; ++rep_) { PHASE_BEGIN f_phase2(a, WSP(bf16_t, WS_HB), WSP(float, WS_PART), WSP(bf16_t, WS_WF), WSP(float, WS_LC), WSP(float, WS_TOT), lds); }
#endif
            }
#ifndef SK_Q
            {
                PHASE_BEGIN
                pg8::Gemm g{WSP(bf16_t, WS_HB), WSP(bf16_t, WS_WQ) + (size_t)j * D * D, M, D, D, 256}; pg8::StaticOrder S; S.init(M, D, G, (int)blockIdx.x);
                EpiScale E{WSP(bf16_t, WS_BUFA), WSP(bf16_t, WS_BUFA), WSP(float, WS_PART), C2, nullptr};
                pg8::gemm_phase<EpiScale, pg8::StaticOrder, true, true>(lds, g, S, E);
            }
#endif
            GSYNC();
#if REP_ANB
            {
                PHASE_BEGIN
                const attn_body::AttnTensors AT{(const attn_body::bf16*)WSP(bf16_t, WS_BUFA), (const attn_body::bf16*)WSP(bf16_t, WS_K), (const attn_body::bf16*)WSP(bf16_t, WS_V), (attn_body::bf16*)(ws + WS_ACT + 64 * MiB), WSP(float, WS_LC), WSP(float, WS_TOT), WSP(float, 61440)};
                const attn_body::StaticOrder AS((int)gridDim.x, (int)blockIdx.x);
                attn_body::attn_phase<attn_body::StaticOrder, 8, false>((char*)lds_raw, AT, AS);
            }
#endif
#ifndef SK_ATTN
#ifdef ATTN_SIMPLE
            { PHASE_BEGIN attn_simple(WSP(bf16_t, WS_BUFA), WSP(bf16_t, WS_K), WSP(bf16_t, WS_V), WSP(bf16_t, WS_BUFA), WSP(float, WS_LC), WSP(float, WS_TOT), lds); }
#else
            for (int rep_ = 0; rep_ < REP_AT; ++rep_) {
                PHASE_BEGIN
                const attn_body::AttnTensors AT{(const attn_body::bf16*)WSP(bf16_t, WS_BUFA), (const attn_body::bf16*)WSP(bf16_t, WS_K), (const attn_body::bf16*)WSP(bf16_t, WS_V), (attn_body::bf16*)WSP(bf16_t, WS_ACT), WSP(float, WS_LC), WSP(float, WS_TOT), WSP(float, 61440)};
                const attn_body::StaticOrder AS((int)gridDim.x, (int)blockIdx.x);
                (void)AS; attn_body::attn_phase_dyn<100>((char*)lds_raw, AT, WSP(unsigned, 62464) + 64 * j);
            }
#endif
#endif
            GSYNC();
#ifndef SK_WO
            {
                PHASE_BEGIN
                pg8::Gemm g{WSP(bf16_t, WS_ACT), WSP(bf16_t, WS_WO) + (size_t)j * D * D, M, D, D, 256}; pg8::StaticOrder S; S.init(M, D, G, (int)blockIdx.x);
                EpiRes E{WSP(bf16_t, WS_HB), WSP(float, WS_PART)};
                pg8::gemm_phase<EpiRes, pg8::StaticOrder, true, true>(lds, g, S, E);
            }
#endif
            GSYNC();
        }
#ifndef SK_FI
        for (int rep_ = 0; rep_ < REP_FI; ++rep_) {
            PHASE_BEGIN
            const bf16_t* Wfi = (l < 2) ? WSP(const bf16_t, WS_WFI01) + (size_t)l * FF2 * D : WSP(const bf16_t, WS_WFI23) + (size_t)(l - 2) * FF2 * D;
            pg8::Gemm g{WSP(bf16_t, WS_HB), Wfi, M, FF2, D, 256}; pg8::StaticOrder S; S.init(M, FF2, G, (int)blockIdx.x);
            EpiConv E{ws, a.in[18] + (size_t)l * 3 * FF2, a.in[19] + (size_t)l * FF2, lds + XCH_OFF, l};
            pg8::gemm_phase<EpiConv, pg8::StaticOrder, true, true>(lds, g, S, E);
        }
#endif
        GSYNC();
#if REP_FOX
        {
            PHASE_BEGIN
            const bf16_t* Wfo = (l < 2) ? WSP(const bf16_t, WS_WFO01) + (size_t)l * D * FF : WSP(const bf16_t, WS_WFO23) + (size_t)(l - 2) * D * FF;
            pg8::Gemm g{WSP(bf16_t, WS_ACT), Wfo, M, D, FF, 256}; pg8::StaticOrder S; S.init(M, D, G, (int)blockIdx.x);
            EpiScale E{WSP(bf16_t, WS_BUFA), WSP(bf16_t, WS_BUFA), WSP(float, WS_PART), 1.0f};
            pg8::gemm_phase<EpiScale, pg8::StaticOrder, true, true>(lds, g, S, E);
        }
#endif
#ifndef SK_FO
        {
            PHASE_BEGIN
            const bf16_t* Wfo = (l < 2) ? WSP(const bf16_t, WS_WFO01) + (size_t)l * D * FF : WSP(const bf16_t, WS_WFO23) + (size_t)(l - 2) * D * FF;
            pg8::Gemm g{WSP(bf16_t, WS_ACT), Wfo, M, D, FF, 256}; pg8::StaticOrder S; S.init(M, D, G, (int)blockIdx.x);
            EpiRes E{WSP(bf16_t, WS_HB), WSP(float, WS_PART)};
            pg8::gemm_phase<EpiRes, pg8::StaticOrder, true, true>(lds, g, S, E);
        }
#endif
        GSYNC();
    }
    {
        PHASE_BEGIN
        int tid_l = threadIdx.x; asm volatile("" : "+v"(tid_l)); const int lane = tid_l & 63, wave = __builtin_amdgcn_readfirstlane(tid_l >> 6);
        const int gw = blockIdx.x * 8 + wave, NGW = G * 8; const float* part = WSP(float, WS_PART); float* hout = a.out;
        for (int m = gw; m < M; m += NGW) {
            const float rstd = rstd_row_wave(part, m, lane);
            __attribute__((address_space(1))) f32x4* xr = GASP(f32x4, hout + (size_t)m * D) + lane; const __attribute__((address_space(1))) f32x4* gf = GASP(const f32x4, a.in[21]) + lane; const __attribute__((address_space(1))) u32x2* hr = GASP(const u32x2, WSP(bf16_t, WS_HB) + (size_t)m * D) + lane;
#pragma unroll
            for (int j = 0; j < 4; ++j) { const u32x2 hw = hr[64 * j]; const f32x4 gg = gf[64 * j]; f32x4 v;
                v[0] = __builtin_bit_cast(float, hw.x << 16); v[1] = __builtin_bit_cast(float, hw.x & 0xffff0000u); v[2] = __builtin_bit_cast(float, hw.y << 16); v[3] = __builtin_bit_cast(float, hw.y & 0xffff0000u);
                v = v * rstd * gg; xr[64 * j] = v; }
        }
    }
}
}

extern "C" void kernel_launch(void* const* d_in, const int* in_sizes, int n_in, void* d_out, int out_size, void* d_ws, size_t ws_size, hipStream_t stream) {
    static int grid = 0;
    if (grid == 0) {
        if (n_in != 22 || out_size != yk::M * yk::D || ws_size < yk::WS_END) { fprintf(stderr, "kernel_launch: unexpected shapes (n_in %d out %d ws %zu)\n", n_in, out_size, ws_size); grid = -1; return; }
        int dev = 0, cus = 0, per_cu = 0;
        hipGetDevice(&dev); hipDeviceGetAttribute(&cus, hipDeviceAttributeMultiprocessorCount, dev);
        if (hipFuncSetAttribute((const void*)yk::yoco_fwd, hipFuncAttributeMaxDynamicSharedMemorySize, yk::LDS_BYTES) != hipSuccess) { fprintf(stderr, "hipFuncSetAttribute failed\n"); grid = -1; return; }
        if (hipOccupancyMaxActiveBlocksPerMultiprocessor(&per_cu, (const void*)yk::yoco_fwd, 512, yk::LDS_BYTES) != hipSuccess || per_cu < 1) { fprintf(stderr, "occupancy query: %d\n", per_cu); per_cu = 1; }
        (void)hipGetLastError();
        grid = cus * (per_cu > 1 ? 1 : per_cu);
    }
    if (grid < 0) return;
    yk::Args a{};
    for (int i = 0; i < 22; ++i) a.in[i] = (const float*)d_in[i];
    a.out = (float*)d_out; a.ws = (unsigned char*)d_ws;
    if (hipMemsetAsync(d_ws, 0, 65536, stream) != hipSuccess) { fprintf(stderr, "memset failed\n"); return; }
    void* args[] = {&a};
    hipError_t e = hipLaunchCooperativeKernel((const void*)yk::yoco_fwd, dim3(grid), dim3(512), args, yk::LDS_BYTES, stream);
    if (e != hipSuccess) fprintf(stderr, "cooperative launch failed: %s (grid %d)\n", hipGetErrorString(e), grid);
}
```

```cpp
#include <hip/hip_runtime.h>
#include <hip/hip_cooperative_groups.h>
#include <cstdio>
#include <cstdint>
namespace cg = cooperative_groups;
namespace pg8 {
#define PG8_LAS __attribute__((address_space(3)))
typedef unsigned short bf16_t;
typedef short bf16x8 __attribute__((ext_vector_type(8)));
typedef float f32x4 __attribute__((ext_vector_type(4)));
typedef unsigned u32x4 __attribute__((ext_vector_type(4)));
constexpr int BM = 256, BK = 64, HALF = 128, HTB = HALF * BK * 2  , STAGE_BYTES = 8 * HTB, NXCD = 8, WGM = 4;

__host__ __device__ __forceinline__ int lds_byte(int r, int c) { const int st = (r >> 4) * 2 + (c >> 5), rr = r & 15, cc = c & 31, ob = rr * 64 + cc * 2; return st * 1024 + (ob ^ (((ob >> 9) & 1) << 5)); }
__host__ __device__ __forceinline__ void stage_rc(int b, int& R, int& C) { const int st = b / 1024, sb = b % 1024, swz = sb ^ (((sb >> 9) & 1) << 5); R = (st >> 1) * 16 + swz / 64; C = (st & 1) * 32 + (swz % 64) / 2; }
__host__ __device__ __forceinline__ int perm32(int rho) { const int n = rho >> 4, i = rho & 15; return 8 * (i >> 2) + 4 * n + (i & 3); }

struct Unit { int pm, pn; };
struct Gemm { const bf16_t* A; const bf16_t* Bt; int M, N, K; int a_tile_rows; };

struct StaticOrder {
    int nM, nN, nwg, G, c;
    __host__ __device__ void init(int M, int N, int G_, int c_) { nM = M / BM; nN = N / BM; nwg = nM * nN; G = G_; c = c_; }
    __host__ __device__ void init2(int nM_, int nN_, int G_, int c_) { nM = nM_; nN = nN_; nwg = nM * nN; G = G_; c = c_; }
    __host__ __device__ bool next(int i, Unit& u) const {
        const long L = (long)i * G + c; if (L >= nwg) return false;
        int wgid = (int)L; { const int q = nwg / NXCD, r = nwg % NXCD, xcd = wgid % NXCD, off = wgid / NXCD; wgid = (xcd < r ? xcd * (q + 1) : r * (q + 1) + (xcd - r) * q) + off; }
        const int nig = WGM * nN, gid = wgid / nig, fm = gid * WGM, gsz = (nM - fm) < WGM ? (nM - fm) : WGM;
        u.pm = fm + ((wgid % nig) % gsz); u.pn = (wgid % nig) / gsz; return true;
    }
    __device__ __forceinline__ void a_ready(const Unit&) const {}
    __device__ __forceinline__ void done(const Unit&) const {}
};

__device__ __forceinline__ unsigned cvt_pk_bf16(float lo, float hi) { unsigned r; asm volatile("v_cvt_pk_bf16_f32 %0, %1, %2" : "=v"(r) : "v"(lo), "v"(hi)); return r; }

template <class Epi, class Sched, bool ALIGN_EPI = false, bool SP2 = false>
__device__ __forceinline__ void gemm_phase(PG8_LAS unsigned char* lds, const Gemm g, const Sched& S, const Epi& E) {
    int tid_l = threadIdx.x; asm volatile("" : "+v"(tid_l)); const int tid = tid_l, wid = __builtin_amdgcn_readfirstlane(tid >> 6), lane = tid & 63, wr = wid >> 2, wc = wid & 3, fr = lane & 15, fq = lane >> 4;
    const int K = g.K, nt = K / BK;
    unsigned voffA[2], voffB[2];
#pragma unroll
    for (int i = 0; i < 2; ++i) { int R, C; stage_rc(tid * 16 + i * 8192, R, C); const int Rb = Epi::PERM ? ((R & ~31) + perm32(R & 31)) : R;
        voffA[i] = (unsigned)(R * K + C) * 2u; voffB[i] = (unsigned)(Rb * K + C) * 2u; }
    const size_t kstep = (size_t)(BK * 2);
    const size_t hstep = (size_t)HALF * K * 2;
    const size_t tstep = 2 * hstep; const size_t tstepA = (size_t)g.a_tile_rows * K * 2;
    const unsigned ldsw = (unsigned)wid * 1024u;
    const int aoff = lds_byte(wr * 64 + fr, fq * 8), boff = lds_byte(wc * 32 + fr, fq * 8);
#define PG8_SA(b, h) (((b) * 2 + (h)) * HTB)
#define PG8_SB(b, h) ((4 + (b) * 2 + (h)) * HTB)
#define PG8_STAGE(bufoff, gbase, voff) do { _Pragma("unroll") for (int _i = 0; _i < 2; ++_i) \
        __builtin_amdgcn_global_load_lds((const unsigned*)((const char*)(gbase) + (voff)[_i]), (PG8_LAS unsigned*)(lds + (bufoff) + ldsw + _i * 8192), 16, 0, 0); } while (0)
#define PG8_LDA(dst, b, h) do { _Pragma("unroll") for (int m = 0; m < 4; ++m) _Pragma("unroll") for (int k = 0; k < 2; ++k) dst[m][k] = *(const PG8_LAS bf16x8*)(lds + PG8_SA(b, h) + aoff + m * 2048 + k * 1024); } while (0)
#define PG8_LDB(dst, b, h) do { _Pragma("unroll") for (int n = 0; n < 2; ++n) _Pragma("unroll") for (int k = 0; k < 2; ++k) dst[n][k] = *(const PG8_LAS bf16x8*)(lds + PG8_SB(b, h) + boff + n * 2048 + k * 1024); } while (0)
#define PG8_MMA(ai, bj, At, Bt) do { __builtin_amdgcn_s_setprio(1); _Pragma("unroll") for (int m = 0; m < 4; ++m) _Pragma("unroll") for (int n = 0; n < 2; ++n) _Pragma("unroll") for (int k = 0; k < 2; ++k) \
        acc[ai][bj][m][n] = __builtin_amdgcn_mfma_f32_16x16x32_bf16(Bt[n][k], At[m][k], acc[ai][bj][m][n], 0, 0, 0); __builtin_amdgcn_s_setprio(0); } while (0)
#define PG8_WAIT_V(n) asm volatile("s_waitcnt vmcnt(" #n ")" ::: "memory")
#define PG8_WAIT_L(n) asm volatile("s_waitcnt lgkmcnt(" #n ")" ::: "memory")
#define PG8_BAR __builtin_amdgcn_s_barrier()
#define PG8_SCHED __builtin_amdgcn_sched_barrier(0)
    Unit cur, nxt; int ui = 0;
    if (!S.next(0, cur)) return;
    f32x4 acc[2][2][4][2];
#pragma unroll
    for (int a = 0; a < 2; ++a)
#pragma unroll
        for (int b = 0; b < 2; ++b)
#pragma unroll
            for (int m = 0; m < 4; ++m)
#pragma unroll
                for (int n = 0; n < 2; ++n) acc[a][b][m][n] = (f32x4){0.f, 0.f, 0.f, 0.f};
    bf16x8 At[4][2], B0[2][2], B1[2][2];
    const char* cA = (const char*)g.A + (size_t)cur.pm * tstepA; const char* cB = (const char*)g.Bt + (size_t)cur.pn * tstep;
    S.a_ready(cur);
    if constexpr (SP2) {
        PG8_STAGE(PG8_SB(0, 0), cB, voffB); PG8_STAGE(PG8_SB(0, 1), cB + hstep, voffB); PG8_STAGE(PG8_SA(0, 0), cA, voffA); PG8_STAGE(PG8_SA(0, 1), cA + hstep, voffA);
        if (wr == 1) PG8_BAR;
        PG8_WAIT_V(2); PG8_BAR;
        PG8_STAGE(PG8_SB(1, 0), cB + kstep, voffB); PG8_STAGE(PG8_SA(1, 0), cA + kstep, voffA); PG8_STAGE(PG8_SB(1, 1), cB + hstep + kstep, voffB);
        PG8_WAIT_V(6); PG8_BAR;
    } else {
        PG8_STAGE(PG8_SB(0, 0), cB, voffB); PG8_STAGE(PG8_SA(0, 0), cA, voffA); PG8_STAGE(PG8_SB(0, 1), cB + hstep, voffB); PG8_STAGE(PG8_SA(0, 1), cA + hstep, voffA);
        if (wr == 1) PG8_BAR;
        PG8_WAIT_V(4); PG8_BAR;
        PG8_STAGE(PG8_SB(1, 0), cB + kstep, voffB); PG8_STAGE(PG8_SA(1, 0), cA + kstep, voffA); PG8_STAGE(PG8_SB(1, 1), cB + hstep + kstep, voffB);
        PG8_WAIT_V(6); PG8_BAR;
    }
    for (;;) {
        const bool has_next = S.next(ui + 1, nxt);
        const char* nA = has_next ? (const char*)g.A + (size_t)nxt.pm * tstepA : cA; const char* nB = has_next ? (const char*)g.Bt + (size_t)nxt.pn * tstep : cB;
        for (int t = 0; t < nt; t += 2) {
            const bool last = (t == nt - 2);
            const char* a1 = cA + (size_t)(t + 1) * kstep;
            const char* a2 = last ? nA : cA + (size_t)(t + 2) * kstep; const char* b2 = last ? nB : cB + (size_t)(t + 2) * kstep;
            const char* a3 = a2 + kstep; const char* b3 = b2 + kstep;
            if (last && has_next) S.a_ready(nxt);
            if constexpr (SP2) {
            PG8_LDB(B0, 0, 0); PG8_LDB(B1, 0, 1); PG8_SCHED; PG8_LDA(At, 0, 0); PG8_STAGE(PG8_SA(1, 1), a1 + hstep, voffA);
            PG8_WAIT_V(8); PG8_WAIT_L(0); PG8_BAR; PG8_MMA(0, 0, At, B0); PG8_MMA(0, 1, At, B1); PG8_BAR; PG8_SCHED;
            PG8_LDA(At, 0, 1); PG8_STAGE(PG8_SB(0, 0), b2, voffB); PG8_STAGE(PG8_SB(0, 1), b2 + hstep, voffB); PG8_STAGE(PG8_SA(0, 0), a2, voffA);
            PG8_WAIT_V(8); PG8_WAIT_L(0); PG8_BAR; PG8_MMA(1, 0, At, B0); PG8_MMA(1, 1, At, B1); PG8_BAR; PG8_SCHED;
            PG8_LDB(B0, 1, 0); PG8_LDB(B1, 1, 1); PG8_SCHED; PG8_LDA(At, 1, 0); PG8_STAGE(PG8_SA(0, 1), a2 + hstep, voffA);
            PG8_WAIT_V(8); PG8_WAIT_L(0); PG8_BAR; PG8_MMA(0, 0, At, B0); PG8_MMA(0, 1, At, B1); PG8_BAR; PG8_SCHED;
            PG8_LDA(At, 1, 1); PG8_STAGE(PG8_SB(1, 0), b3, voffB); PG8_STAGE(PG8_SB(1, 1), b3 + hstep, voffB); PG8_STAGE(PG8_SA(1, 0), a3, voffA);
            PG8_WAIT_V(8); PG8_WAIT_L(0); PG8_BAR; PG8_MMA(1, 0, At, B0); PG8_MMA(1, 1, At, B1); PG8_BAR; PG8_SCHED;
            } else {
            PG8_LDB(B0, 0, 0); PG8_SCHED; PG8_LDA(At, 0, 0); PG8_STAGE(PG8_SA(1, 1), a1 + hstep, voffA);
            PG8_WAIT_L(8); PG8_BAR; PG8_WAIT_L(0); PG8_MMA(0, 0, At, B0); PG8_BAR; PG8_SCHED;
            PG8_LDB(B1, 0, 1); PG8_STAGE(PG8_SB(0, 0), b2, voffB);
            PG8_BAR; PG8_WAIT_L(0); PG8_MMA(0, 1, At, B1); PG8_BAR;
            PG8_LDA(At, 0, 1); PG8_STAGE(PG8_SA(0, 0), a2, voffA);
            PG8_BAR; PG8_WAIT_L(0); PG8_MMA(1, 0, At, B0); PG8_BAR; PG8_SCHED;
            PG8_STAGE(PG8_SB(0, 1), b2 + hstep, voffB);
            PG8_WAIT_V(6); PG8_BAR; PG8_MMA(1, 1, At, B1); PG8_BAR;
            PG8_LDB(B0, 1, 0); PG8_SCHED; PG8_LDA(At, 1, 0); PG8_STAGE(PG8_SA(0, 1), a2 + hstep, voffA);
            PG8_WAIT_L(8); PG8_BAR; PG8_WAIT_L(0); PG8_MMA(0, 0, At, B0); PG8_BAR; PG8_SCHED;
            PG8_LDB(B1, 1, 1); PG8_STAGE(PG8_SB(1, 0), b3, voffB);
            PG8_BAR; PG8_WAIT_L(0); PG8_MMA(0, 1, At, B1); PG8_BAR;
            PG8_LDA(At, 1, 1); PG8_STAGE(PG8_SA(1, 0), a3, voffA);
            PG8_BAR; PG8_WAIT_L(0); PG8_MMA(1, 0, At, B0); PG8_BAR; PG8_SCHED;
            PG8_STAGE(PG8_SB(1, 1), b3 + hstep, voffB);
            PG8_WAIT_V(6); PG8_BAR; PG8_MMA(1, 1, At, B1); PG8_BAR;
            }
        }
        if constexpr (ALIGN_EPI) { if (wr == 0) PG8_BAR; }
        if constexpr (!Epi::AFTER_DRAIN) { E(acc, cur, wr, wc, fr, fq); S.done(cur); }
        if (!has_next) break;
#pragma unroll
        for (int a = 0; a < 2; ++a)
#pragma unroll
            for (int b = 0; b < 2; ++b)
#pragma unroll
                for (int m = 0; m < 4; ++m)
#pragma unroll
                    for (int n = 0; n < 2; ++n) acc[a][b][m][n] = (f32x4){0.f, 0.f, 0.f, 0.f};
        cur = nxt; cA = nA; cB = nB; ++ui;
        if constexpr (ALIGN_EPI) { if (wr == 1) PG8_BAR; }
    }
    PG8_WAIT_V(0);
    if constexpr (!ALIGN_EPI) { if (wr == 0) PG8_BAR; }
    PG8_BAR;
    if constexpr (Epi::AFTER_DRAIN) { E.fused(acc, cur, wr, wc, fr, fq, lds, wid, lane); S.done(cur); }
#undef PG8_SA
#undef PG8_SB
#undef PG8_STAGE
#undef PG8_LDA
#undef PG8_LDB
#undef PG8_MMA
#undef PG8_WAIT_V
#undef PG8_WAIT_L
#undef PG8_BAR
#undef PG8_SCHED
}
}


#include <hip/hip_bf16.h>
#include <cmath>
namespace attn_body {
using bf16=__hip_bfloat16;
using bf16x8=__attribute__((ext_vector_type(8)))short;
using s16x4=__attribute__((ext_vector_type(4)))short;
using f32x16=__attribute__((ext_vector_type(16)))float;
using u32x4=__attribute__((ext_vector_type(4)))unsigned;
constexpr int BATCH=8,NHEAD=16,SEQ=4096,D=64,DM=NHEAD*D;
constexpr int NW=8,QBLK=32,QB=QBLK*NW,KVBLK=64,NQB=SEQ/QB;
constexpr int ATTN_PITCH=DM, ATTN_UNIT_ROWS=QB;
__device__ __forceinline__ int crow(int r,int hi){return (r&3)+8*(r>>2)+4*hi;}
#define SBAR() __builtin_amdgcn_sched_barrier(0)
__device__ __forceinline__ void cmask(f32x16&p0,f32x16&p1,int jb,int qrel,int hi){
  const float NEG=-INFINITY; int kb=64*jb+4*hi;
  #pragma unroll
  for(int r=0;r<16;++r){int kv=kb+(r&3)+8*(r>>2); if(kv>qrel)p0[r]=NEG; if(kv+32>qrel)p1[r]=NEG;}
}

constexpr int NSLOT=3, SLOTB=8192;
constexpr int LDS_K=0, LDS_V=NSLOT*SLOTB, LDS_WS=2*NSLOT*SLOTB, LDS_OST=LDS_WS+NW*64*4, LDS_BIAS=LDS_OST+NW*4096, LDS_BYTES=LDS_BIAS+SEQ*4+256;
constexpr float C2=0.125f*1.4426950408889634f;
__device__ __forceinline__ void glds16(const void*gsrc,unsigned lds_dst){unsigned keep;
  asm volatile("s_mov_b32 %0, m0\n\ts_mov_b32 m0, %2\n\ts_nop 0\n\tglobal_load_lds_dwordx4 %1, off\n\ts_mov_b32 m0, %0":"=&s"(keep):"v"(gsrc),"s"(lds_dst):"memory");}
__device__ __forceinline__ float max3f(float a,float b,float c){float r;asm("v_max3_f32 %0, %1, %2, %3":"=v"(r):"v"(a),"v"(b),"v"(c));return r;}
__device__ __forceinline__ float max2f(float a,float b){float r;asm("v_max_f32_e32 %0, %1, %2":"=v"(r):"v"(a),"v"(b));return r;}
__device__ __forceinline__ float fadd_s(float a,float b){float r;asm("v_add_f32_e32 %0, %1, %2":"=v"(r):"v"(a),"v"(b));return r;}
__device__ __forceinline__ float fsub_s(float a,float b){float r;asm("v_sub_f32_e32 %0, %1, %2":"=v"(r):"v"(a),"v"(b));return r;}
typedef float f32x2_t __attribute__((ext_vector_type(2))); typedef __bf16 bf16x2_t __attribute__((ext_vector_type(2)));
__device__ __forceinline__ unsigned cvtpk_s(float lo,float hi){f32x2_t v={lo,hi};bf16x2_t b=__builtin_convertvector(v,bf16x2_t);return __builtin_bit_cast(unsigned,b);}
#define WAIT_BAR(N) asm volatile("s_waitcnt vmcnt(" #N ") lgkmcnt(0)\n\ts_barrier":::"memory")

__device__ __forceinline__ void qkt(f32x16&p0,f32x16&p1,const char*Kslot,const bf16x8*qr,const f32x16&c0i,const f32x16&c1i,int r32,int hi){
  const char*kb=Kslot+hi*1024+r32*16;
  #pragma unroll
  for(int d0=0;d0<4;++d0){
    const bf16x8 b0=*reinterpret_cast<const bf16x8*>(kb+d0*2048);
    const bf16x8 b1=*reinterpret_cast<const bf16x8*>(kb+d0*2048+512);
    if(d0==0){p0=__builtin_amdgcn_mfma_f32_32x32x16_bf16(b0,qr[0],c0i,0,0,0);p1=__builtin_amdgcn_mfma_f32_32x32x16_bf16(b1,qr[0],c1i,0,0,0);}
    else{p0=__builtin_amdgcn_mfma_f32_32x32x16_bf16(b0,qr[d0],p0,0,0,0);p1=__builtin_amdgcn_mfma_f32_32x32x16_bf16(b1,qr[d0],p1,0,0,0);}}
}
typedef __attribute__((address_space(3))) const char* lds_cptr;
typedef short v4i16_t __attribute__((ext_vector_type(4)));
__device__ __forceinline__ void kload8(bf16x8*kf,lds_cptr kp){
  kf[0]=*(const __attribute__((address_space(3))) bf16x8*)(kp);      kf[1]=*(const __attribute__((address_space(3))) bf16x8*)(kp+512);
  kf[2]=*(const __attribute__((address_space(3))) bf16x8*)(kp+2048); kf[3]=*(const __attribute__((address_space(3))) bf16x8*)(kp+2560);
  kf[4]=*(const __attribute__((address_space(3))) bf16x8*)(kp+4096); kf[5]=*(const __attribute__((address_space(3))) bf16x8*)(kp+4608);
  kf[6]=*(const __attribute__((address_space(3))) bf16x8*)(kp+6144); kf[7]=*(const __attribute__((address_space(3))) bf16x8*)(kp+6656);
}
__device__ __forceinline__ void kload2(bf16x8*kf,lds_cptr kp,int j){ kf[2*j]=*(const __attribute__((address_space(3))) bf16x8*)(kp+j*2048); kf[2*j+1]=*(const __attribute__((address_space(3))) bf16x8*)(kp+j*2048+512); }
__device__ __forceinline__ s16x4 vtr(lds_cptr p){ return __builtin_bit_cast(s16x4,__builtin_amdgcn_ds_read_tr16_b64_v4i16((__attribute__((address_space(3))) v4i16_t*)p)); }
__device__ __forceinline__ float rowmax(const f32x16&p0,const f32x16&p1){
  float a=max3f(p0[0],p0[1],p1[0]),b=max3f(p0[2],p0[3],p1[1]);a=max3f(a,p1[2],p1[3]);
  #pragma unroll
  for(int r=4;r<16;r+=4){a=max3f(a,p0[r],p0[r+1]);b=max3f(b,p0[r+2],p0[r+3]);a=max3f(a,p1[r],p1[r+1]);b=max3f(b,p1[r+2],p1[r+3]);}
  const float m=max2f(a,b);
  auto rr=__builtin_amdgcn_permlane32_swap(__float_as_uint(m),__float_as_uint(m),false,false);
  return max2f(__uint_as_float(rr[0]),__uint_as_float(rr[1]));
}
__device__ __forceinline__ void pv(f32x16*o,int vb,bf16x8 pa0,bf16x8 pa1,bf16x8 pa2,bf16x8 pa3){
  #pragma unroll
  for(int d0=0;d0<2;++d0){s16x4 lo[4],hi[4];
    #pragma unroll
    for(int ks=0;ks<4;++ks){
      asm volatile("ds_read_b64_tr_b16 %0,%1 offset:%c2":"=&v"(lo[ks]):"v"(vb),"i"(d0*4096+ks*1024):"memory");
      asm volatile("ds_read_b64_tr_b16 %0,%1 offset:%c2":"=&v"(hi[ks]):"v"(vb),"i"(d0*4096+ks*1024+512):"memory");}
    asm volatile("s_waitcnt lgkmcnt(0)":::"memory");SBAR();
    #define PK(k) (bf16x8){lo[k][0],lo[k][1],lo[k][2],lo[k][3],hi[k][0],hi[k][1],hi[k][2],hi[k][3]}
    o[d0]=__builtin_amdgcn_mfma_f32_32x32x16_bf16(pa0,PK(0),o[d0],0,0,0);
    o[d0]=__builtin_amdgcn_mfma_f32_32x32x16_bf16(pa1,PK(1),o[d0],0,0,0);
    o[d0]=__builtin_amdgcn_mfma_f32_32x32x16_bf16(pa2,PK(2),o[d0],0,0,0);
    o[d0]=__builtin_amdgcn_mfma_f32_32x32x16_bf16(pa3,PK(3),o[d0],0,0,0);
    #undef PK
  }
}

#ifndef ATTN_STORE16
#define ATTN_STORE16(p,v) (*(__attribute__((address_space(1))) u32x4*)(p)=(v))
#endif
template<int THRL,bool BIAS> __device__ __forceinline__ void attn_unit(int b,int h,int qb,const bf16*Q,const bf16*__restrict__ K,const bf16*__restrict__ V,bf16*O,const float*LCbh,const float*KMAXbh,char*shm){
  int tid_l_=threadIdx.x; asm volatile("":"+v"(tid_l_)); const int tid=tid_l_,lane=tid&63,r32=lane&31,hi=lane>>5; const int wid=__builtin_amdgcn_readfirstlane(tid>>6);
  const long rowbase=(long)b*SEQ; const int q0=qb*QB;
  const bf16*Qw=Q+(rowbase+q0+wid*QBLK)*DM+h*D;
  const bf16*Kh=K+rowbase*DM+h*D,*Vh=V+rowbase*DM+h*D;
  const unsigned lds0=(unsigned)(uintptr_t)shm;
  float*wsf=(float*)(shm+LDS_WS)+wid*64;
  const unsigned kdst=lds0+LDS_K+wid*1024, vdst=lds0+LDS_V+wid*1024;
  #define DMA_K(t,slot) glds16(ksrc+(long)(t)*KVBLK*DM,(unsigned)__builtin_amdgcn_readfirstlane(kdst+(slot)))
  #define DMA_V(t,slot) glds16(vsrc+(long)(t)*KVBLK*DM,(unsigned)__builtin_amdgcn_readfirstlane(vdst+(slot)))
  const int vb0=(int)(lds0+LDS_V)+((lane>>4)&1)*32+(lane&3)*8+(4*hi+((lane&15)>>2))*64;
  const char*Kbase=shm+LDS_K; bf16x8 kf[8];
  const lds_cptr shm3=(lds_cptr)shm; const lds_cptr kp0=shm3+LDS_K+hi*1024+r32*16; const lds_cptr vp0=shm3+LDS_V+((lane>>4)&1)*32+(lane&3)*8+(4*hi+((lane&15)>>2))*64;
  typedef float f32x4b __attribute__((ext_vector_type(4)));
  #define BIASLD(B0,B1,t) do{ int hl_=hi; asm volatile("":"+v"(hl_)); const __attribute__((address_space(3))) f32x4b* bp_=(const __attribute__((address_space(3))) f32x4b*)(shm3+LDS_BIAS+boff+hl_*16+(t)*256); \
    _Pragma("unroll") for(int k_=0;k_<4;++k_){ const f32x4b x_=bp_[2*k_], y_=bp_[8+2*k_]; \
      if(BIAS){B0[4*k_]=x_[0]-mhat;B0[4*k_+1]=x_[1]-mhat;B0[4*k_+2]=x_[2]-mhat;B0[4*k_+3]=x_[3]-mhat; B1[4*k_]=y_[0]-mhat;B1[4*k_+1]=y_[1]-mhat;B1[4*k_+2]=y_[2]-mhat;B1[4*k_+3]=y_[3]-mhat;}else{B0[4*k_]=-mhat;B0[4*k_+1]=-mhat;B0[4*k_+2]=-mhat;B0[4*k_+3]=-mhat;B1[4*k_]=-mhat;B1[4*k_+1]=-mhat;B1[4*k_+2]=-mhat;B1[4*k_+3]=-mhat;} } }while(0)
  bf16x8 qr[4];
  #pragma unroll
  for(int d0=0;d0<4;++d0)qr[d0]=*(const __attribute__((address_space(1))) bf16x8*)(&Qw[(long)r32*DM+d0*16+hi*8]);
  int t0=0; const int NTF=(q0+QB)/KVBLK;
  if(BIAS){
    float qn=0.f;
    #pragma unroll
    for(int d0=0;d0<4;++d0){
      #pragma unroll
      for(int e=0;e<8;++e){ const float x=__builtin_bit_cast(float,(unsigned)(unsigned short)qr[d0][e]<<16); qn+=x*x; } }
    qn+=__shfl_xor(qn,32);
    #pragma unroll
    for(int o_=1;o_<32;o_<<=1)qn=fmaxf(qn,__shfl_xor(qn,o_));
    __attribute__((address_space(3))) float* qx=(__attribute__((address_space(3))) float*)(shm3+LDS_BIAS+SEQ*4+128);
    if(lane==0)qx[wid]=qn;
    asm volatile("s_waitcnt lgkmcnt(0)\n\ts_barrier":::"memory");
    float qmax2=0.f;
    #pragma unroll
    for(int w_=0;w_<NW;++w_)qmax2=fmaxf(qmax2,qx[w_]);
    const float kmax2=((const __attribute__((address_space(1))) float*)KMAXbh)[0]+((const __attribute__((address_space(1))) float*)KMAXbh)[1];
    const float Bqk=sqrtf(qmax2*kmax2)*1.02f;
    const __attribute__((address_space(3))) float* beta=(const __attribute__((address_space(3))) float*)(shm3+LDS_BIAS);
    const float thr=beta[q0]-(40.0f+2.0f*Bqk);
    int lo_=0,hi_=NTF-4;
    while(lo_<hi_){ const int mid_=(lo_+hi_)>>1; if(beta[64*mid_+63]<thr)lo_=mid_+1; else hi_=mid_; }
    t0=__builtin_amdgcn_readfirstlane(lo_&~1);
  }
  const int NT=NTF-t0;
  const bf16*ksrc=Kh+(long)(t0*KVBLK+lane)*DM+wid*8;
  const bf16*vsrc=Vh+(long)(t0*KVBLK+16*(wid&3)+(lane>>2))*DM+(wid>>2)*32+(lane&3)*8;
  const int boff=t0*256;
  DMA_K(0,0);DMA_V(0,0);DMA_K(1,SLOTB);
  float mhat=0.f,l_reg=0.f;f32x16 o[2];o[0]=f32x16{};o[1]=f32x16{};
  const int qrel=wid*QBLK+r32;
  #define CMASK(P0,P1,t) do{int jb_=(t)-(NT-4); if(jb_>=0)cmask(P0,P1,jb_,qrel,hi);}while(0)
  bool resc=false;
  #define START(P0,P1) do{ const float rm=rowmax(P0,P1); resc=false; \
    { const float dl=rm; mhat=fadd_s(mhat,dl); \
      _Pragma("unroll") for(int r=0;r<16;++r){P0[r]=fsub_s(P0[r],dl);P1[r]=fsub_s(P1[r],dl);} } \
    _Pragma("unroll") for(int r=0;r<16;++r)P0[r]=__builtin_amdgcn_exp2f(P0[r]); }while(0)
  #define RESC() do{ if(resc){ asm volatile("s_waitcnt lgkmcnt(0)":::"memory"); \
      _Pragma("unroll") for(int d_=0;d_<2;++d_) _Pragma("unroll") for(int r=0;r<16;++r)o[d_][r]*=wsf[crow(r,hi)]; } }while(0)
  f32x16 pA0,pA1,pB0,pB1;
  int sl_prev=0,sl_cur=0,sl_next=SLOTB;
  #define ROT() do{sl_prev=sl_cur;sl_cur=sl_next;sl_next=(sl_next==(NSLOT-1)*SLOTB)?0:sl_next+SLOTB;}while(0)
  DMA_K(2,2*SLOTB);
  WAIT_BAR(3);
  { f32x16 ci0,ci1; BIASLD(ci0,ci1,0); qkt(pA0,pA1,Kbase,qr,ci0,ci1,r32,hi); } asm volatile("s_nop 15\n\ts_nop 7":"+v"(pA0),"+v"(pA1));CMASK(pA0,pA1,0);
  START(pA0,pA1);
  _Pragma("unroll") for(int r=0;r<16;++r)pA1[r]=__builtin_amdgcn_exp2f(pA1[r]);
  WAIT_BAR(0);
  DMA_K(3,0);DMA_V(1,SLOTB);
  ROT();
  kload8(kf,kp0+sl_cur);
  WAIT_BAR(2);
  s16x4 vlo[8],vhi[8]; u32x4 pw0,pw1,pw2,pw3;
  #define PKW(P,B) cvtpk_s(P[B],P[B+1])
  #define PAF(k) __builtin_bit_cast(bf16x8,pw##k)
  #define VFR(i) (bf16x8){vlo[i][0],vlo[i][1],vlo[i][2],vlo[i][3],vhi[i][0],vhi[i][1],vhi[i][2],vhi[i][3]}
  #define PIN(x) asm volatile("":"+v"(x))
  #define MX3(a,b,c) __builtin_fmaxf(__builtin_fmaxf((a),(b)),(c))
  #define GAPA(MF,A0,A1,A2,A3,W0,W1,PW) do{ MF; sacc+=A0; sacc+=A1; sacc+=A2; sacc+=A3; PIN(sacc); W0; W1; PIN(PW); SBAR(); }while(0)
  #define EX(v) __builtin_amdgcn_exp2f(v)
  #define GAPB(MF,X,B) do{ MF; X[B]=EX(X[B]); X[B+1]=EX(X[B+1]); X[B+2]=EX(X[B+2]); X[B+3]=EX(X[B+3]); PIN(X); SBAR(); }while(0)
  #define VRD(i) do{ vlo[i]=vtr(vp_+(((i)>>2)*4096+((i)&3)*1024)); vhi[i]=vtr(vp_+(((i)>>2)*4096+((i)&3)*1024+512)); }while(0)
  #define KRD(G,j) do{ if(G){ kload2(kf,kp0+sl_next,j); SBAR(); } }while(0)
  #define STEP(C0,C1,P0,P1,t,GK,GV,GL) do{ SBAR(); BIASLD(C0,C1,t); SBAR(); \
    const lds_cptr vp_=vp0+sl_prev; \
    VRD(0); SBAR(); float sacc=(P0[0]+P0[1]); \
    GAPA(C0=__builtin_amdgcn_mfma_f32_32x32x16_bf16(kf[0],qr[0],C0,0,0,0), P0[2],P0[3],P0[4],P0[5],     pw0[0]=PKW(P0,0), pw0[1]=PKW(P0,2), pw0); \
    VRD(4); SBAR(); GAPA(C1=__builtin_amdgcn_mfma_f32_32x32x16_bf16(kf[1],qr[0],C1,0,0,0), P0[6],P0[7],P0[8],P0[9],     pw0[2]=PKW(P0,4), pw0[3]=PKW(P0,6), pw0); \
    VRD(1); SBAR(); GAPA(C0=__builtin_amdgcn_mfma_f32_32x32x16_bf16(kf[2],qr[1],C0,0,0,0),   P0[10],P0[11],P0[12],P0[13], pw1[0]=PKW(P0,8), pw1[1]=PKW(P0,10), pw1); \
    VRD(5); SBAR(); GAPA(C1=__builtin_amdgcn_mfma_f32_32x32x16_bf16(kf[3],qr[1],C1,0,0,0),   P0[14],P0[15],P1[0],P1[1],   pw1[2]=PKW(P0,12),pw1[3]=PKW(P0,14), pw1); \
    VRD(2); SBAR(); GAPA(C0=__builtin_amdgcn_mfma_f32_32x32x16_bf16(kf[4],qr[2],C0,0,0,0),   P1[2],P1[3],P1[4],P1[5],     pw2[0]=PKW(P1,0), pw2[1]=PKW(P1,2), pw2); \
    VRD(6); SBAR(); GAPA(C1=__builtin_amdgcn_mfma_f32_32x32x16_bf16(kf[5],qr[2],C1,0,0,0),   P1[6],P1[7],P1[8],P1[9],     pw2[2]=PKW(P1,4), pw2[3]=PKW(P1,6), pw2); \
    VRD(3); SBAR(); GAPA(C0=__builtin_amdgcn_mfma_f32_32x32x16_bf16(kf[6],qr[3],C0,0,0,0),   P1[10],P1[11],P1[12],P1[13], pw3[0]=PKW(P1,8), pw3[1]=PKW(P1,10), pw3); \
    VRD(7); SBAR(); GAPA(C1=__builtin_amdgcn_mfma_f32_32x32x16_bf16(kf[7],qr[3],C1,0,0,0),   P1[14],P1[15],0.f,0.f,       pw3[2]=PKW(P1,12),pw3[3]=PKW(P1,14), pw3); \
    l_reg+=sacc; \
    if(GK){DMA_K((t)+3,sl_cur);} if(GV){DMA_V((t)+1,sl_next);} \
    CMASK(C0,C1,t); \
    { float a=MX3(C0[0],C0[1],C1[0]),b=MX3(C0[2],C0[3],C1[1]); a=MX3(a,C1[2],C1[3]); \
      _Pragma("unroll") for(int r=4;r<16;r+=4){a=MX3(a,C0[r],C0[r+1]);b=MX3(b,C0[r+2],C0[r+3]);a=MX3(a,C1[r],C1[r+1]);b=MX3(b,C1[r+2],C1[r+3]);} \
      float rm=__builtin_fmaxf(a,b); { auto rr=__builtin_amdgcn_permlane32_swap(__float_as_uint(rm),__float_as_uint(rm),false,false); rm=__builtin_fmaxf(__uint_as_float(rr[0]),__uint_as_float(rr[1])); } \
      resc=false; \
      if(__builtin_expect(__any(rm>(float)THRL),0)){ const float dl=__builtin_fmaxf(rm,0.f); mhat+=dl; \
        _Pragma("unroll") for(int r=0;r<16;++r){C0[r]-=dl;C1[r]-=dl;} \
        const float f=__builtin_amdgcn_exp2f(-dl); l_reg*=f; if(hi==0)wsf[r32]=f; resc=true; } } \
    SBAR(); \
    GAPB(o[0]=__builtin_amdgcn_mfma_f32_32x32x16_bf16(PAF(0),VFR(0),o[0],0,0,0), C0,0); \
    GAPB(o[1]=__builtin_amdgcn_mfma_f32_32x32x16_bf16(PAF(0),VFR(4),o[1],0,0,0), C0,4); \
    KRD(GL,0); GAPB(o[0]=__builtin_amdgcn_mfma_f32_32x32x16_bf16(PAF(1),VFR(1),o[0],0,0,0), C0,8); \
    KRD(GL,1); GAPB(o[1]=__builtin_amdgcn_mfma_f32_32x32x16_bf16(PAF(1),VFR(5),o[1],0,0,0), C0,12); \
    KRD(GL,2); GAPB(o[0]=__builtin_amdgcn_mfma_f32_32x32x16_bf16(PAF(2),VFR(2),o[0],0,0,0), C1,0); \
    KRD(GL,3); GAPB(o[1]=__builtin_amdgcn_mfma_f32_32x32x16_bf16(PAF(2),VFR(6),o[1],0,0,0), C1,4); \
    GAPB(o[0]=__builtin_amdgcn_mfma_f32_32x32x16_bf16(PAF(3),VFR(3),o[0],0,0,0), C1,8); \
    GAPB(o[1]=__builtin_amdgcn_mfma_f32_32x32x16_bf16(PAF(3),VFR(7),o[1],0,0,0), C1,12); \
    }while(0)
  int t=1;
  #undef CMASK
  #define CMASK(P0,P1,t) do{}while(0)
  for(;t+5<NT;t+=2){
    STEP(pB0,pB1,pA0,pA1,t,true,true,true);     WAIT_BAR(2); RESC(); ROT();
    STEP(pA0,pA1,pB0,pB1,t+1,true,true,true);   WAIT_BAR(2); RESC(); ROT();
  }
  #undef CMASK
  #define CMASK(P0,P1,t) do{int jb_=(t)-(NT-4); if(jb_>=0)cmask(P0,P1,jb_,qrel,hi);}while(0)
  #define ENDW(tt) do{ if((tt)+3<NT){WAIT_BAR(2);} else if((tt)+2<NT){WAIT_BAR(1);} else {WAIT_BAR(0);} }while(0)
  for(;t+1<NT;t+=2){
    STEP(pB0,pB1,pA0,pA1,t,(t+3<NT),(t+1<NT),(t+1<NT));       ENDW(t);   RESC(); ROT();
    STEP(pA0,pA1,pB0,pB1,t+1,(t+4<NT),(t+2<NT),(t+2<NT));     ENDW(t+1); RESC(); ROT();
  }
  STEP(pB0,pB1,pA0,pA1,NT-1,false,false,false); RESC();
  { float sacc=pB0[0]+pB0[1]; _Pragma("unroll") for(int r=2;r<16;++r)sacc+=pB0[r]; _Pragma("unroll") for(int r=0;r<16;++r)sacc+=pB1[r]; l_reg+=sacc;
    pw0=(u32x4){PKW(pB0,0),PKW(pB0,2),PKW(pB0,4),PKW(pB0,6)};pw1=(u32x4){PKW(pB0,8),PKW(pB0,10),PKW(pB0,12),PKW(pB0,14)};pw2=(u32x4){PKW(pB1,0),PKW(pB1,2),PKW(pB1,4),PKW(pB1,6)};pw3=(u32x4){PKW(pB1,8),PKW(pB1,10),PKW(pB1,12),PKW(pB1,14)};
    SBAR(); pv(o,vb0+sl_cur,PAF(0),PAF(1),PAF(2),PAF(3)); }
  #undef PKW
  #undef PAF
  #undef VFR
  #undef PIN
  #undef MX3
  #undef GAPA
  #undef GAPB
  #undef EX
  #undef VRD
  #undef KRD
  #undef STEP
  #undef ENDW
  {auto rr=__builtin_amdgcn_permlane32_swap(__float_as_uint(l_reg),__float_as_uint(l_reg),false,false);l_reg=__uint_as_float(rr[0])+__uint_as_float(rr[1]);}
  if(hi==0)wsf[32+r32]=l_reg;asm volatile("s_waitcnt lgkmcnt(0)":::"memory");
  float rli[16];
  #pragma unroll
  for(int r=0;r<16;++r)rli[r]=__builtin_amdgcn_rcpf(wsf[32+crow(r,hi)]);
  bf16*Ow=O+(rowbase+q0+wid*QBLK)*DM+h*D;
  { bf16*stg=(bf16*)(shm+LDS_OST)+wid*2048;
    #pragma unroll
    for(int r=0;r<16;++r){const int orow=crow(r,hi);
      #pragma unroll
      for(int d0=0;d0<2;++d0)stg[orow*64+d0*32+r32]=__float2bfloat16(o[d0][r]*rli[r]);}
    asm volatile("s_waitcnt lgkmcnt(0)":::"memory");
    #pragma unroll
    for(int i=0;i<4;++i){const int row=i*8+(lane>>3),ch=lane&7; const u32x4 v=*(const u32x4*)(stg+row*64+ch*8); ATTN_STORE16(Ow+(long)row*DM+ch*8,v);} }
  asm volatile("s_waitcnt lgkmcnt(0)\n\ts_barrier":::"memory");
  #undef BIASLD
  #undef DMA_K
  #undef DMA_V
  #undef CMASK
  #undef START
  #undef RESC
  #undef ROT
}
constexpr int ATTN_LDS_BYTES=LDS_BYTES;
struct AttnTensors { const bf16* Q; const bf16* K; const bf16* V; bf16* O; const float* LC; const float* TOT; const float* KMAX; };
struct AttnUnit { int bh; int qb; };
struct StaticOrder {
  int vcu,G;
  __device__ __forceinline__ explicit StaticOrder(int grid,int block):vcu((grid%8==0)?(block%8)*(grid/8)+block/8:block),G(grid){}
  __device__ __forceinline__ bool next(int i,AttnUnit&u)const{
    if(G==256){ if(i>=8)return false; const int s=4*(vcu&1)+(i>>1); u.bh=vcu>>1; u.qb=(i&1)?15-s:s; return true; }
    const int U=i*G+vcu; if(U>=BATCH*NHEAD*NQB)return false; u.bh=U/NQB; u.qb=U%NQB; return true; }
  __device__ __forceinline__ void a_ready(const AttnUnit&)const{}
  __device__ __forceinline__ void done(const AttnUnit&)const{}
};
template<class Sched,int THRL=100,bool BIAS=true> __device__ __forceinline__ void attn_phase(char*lds,const AttnTensors&T,const Sched&S){
  AttnUnit u; int cur_bh=-1;
  for(int i=0;S.next(i,u);++i){ S.a_ready(u);
    if(u.bh!=cur_bh){
      cur_bh=u.bh; typedef float f32x4b __attribute__((ext_vector_type(4)));
      int tl_=threadIdx.x; asm volatile("":"+v"(tl_)); const int j0=tl_*8, c0=j0>>7; const float*TOTbh=T.TOT+u.bh*32; const float*LCbh=T.LC+(long)u.bh*SEQ;
      float off=0.f;
      #pragma unroll
      for(int c=0;c<32;++c){ const float tv=((const __attribute__((address_space(1))) float*)TOTbh)[c]; off+=(c<c0)?tv:0.f; }
      const f32x4b a=*(const __attribute__((address_space(1))) f32x4b*)(LCbh+j0), bq=*(const __attribute__((address_space(1))) f32x4b*)(LCbh+j0+4);
      __attribute__((address_space(3))) float* bt=(__attribute__((address_space(3))) float*)((__attribute__((address_space(3))) char*)lds+LDS_BIAS);
      *(__attribute__((address_space(3))) f32x4b*)(bt+j0)=(f32x4b){-(a[0]+off)*1.4426950408889634f,-(a[1]+off)*1.4426950408889634f,-(a[2]+off)*1.4426950408889634f,-(a[3]+off)*1.4426950408889634f};
      *(__attribute__((address_space(3))) f32x4b*)(bt+j0+4)=(f32x4b){-(bq[0]+off)*1.4426950408889634f,-(bq[1]+off)*1.4426950408889634f,-(bq[2]+off)*1.4426950408889634f,-(bq[3]+off)*1.4426950408889634f}; } attn_unit<THRL,BIAS>(u.bh/NHEAD,u.bh%NHEAD,u.qb,T.Q,T.K,T.V,T.O,T.LC+(long)u.bh*SEQ,T.KMAX+u.bh*2,lds); S.done(u); }
}
template<int THRL=100> __device__ __forceinline__ void attn_phase_dyn(char*lds,const AttnTensors&T,unsigned*counter){
  int cur_bh=-1;
  __attribute__((address_space(3))) unsigned* slot=(__attribute__((address_space(3))) unsigned*)((__attribute__((address_space(3))) char*)lds+LDS_BIAS+SEQ*4+192);
  for(;;){
    int tl_=threadIdx.x; asm volatile("":"+v"(tl_));
    if(tl_==0){ *slot=__hip_atomic_fetch_add(counter,1u,__ATOMIC_RELAXED,__HIP_MEMORY_SCOPE_AGENT); }
    asm volatile("s_waitcnt vmcnt(0) lgkmcnt(0)\n\ts_barrier":::"memory");
    const unsigned U=__builtin_amdgcn_readfirstlane(*slot);
    if(U>=(unsigned)(BATCH*NHEAD*NQB))break;
    const int bh=(int)(U>>4), qb=15-(int)(U&15);
    if(bh!=cur_bh){
      cur_bh=bh; typedef float f32x4b __attribute__((ext_vector_type(4)));
      const int j0=tl_*8, c0=j0>>7; const float*TOTbh=T.TOT+bh*32; const float*LCbh=T.LC+(long)bh*SEQ;
      float off=0.f;
      #pragma unroll
      for(int c=0;c<32;++c){ const float tv=((const __attribute__((address_space(1))) float*)TOTbh)[c]; off+=(c<c0)?tv:0.f; }
      const f32x4b a=*(const __attribute__((address_space(1))) f32x4b*)(LCbh+j0), bq=*(const __attribute__((address_space(1))) f32x4b*)(LCbh+j0+4);
      __attribute__((address_space(3))) float* bt=(__attribute__((address_space(3))) float*)((__attribute__((address_space(3))) char*)lds+LDS_BIAS);
      *(__attribute__((address_space(3))) f32x4b*)(bt+j0)=(f32x4b){-(a[0]+off)*1.4426950408889634f,-(a[1]+off)*1.4426950408889634f,-(a[2]+off)*1.4426950408889634f,-(a[3]+off)*1.4426950408889634f};
      *(__attribute__((address_space(3))) f32x4b*)(bt+j0+4)=(f32x4b){-(bq[0]+off)*1.4426950408889634f,-(bq[1]+off)*1.4426950408889634f,-(bq[2]+off)*1.4426950408889634f,-(bq[3]+off)*1.4426950408889634f}; }
    attn_unit<THRL,true>(bh/NHEAD,bh%NHEAD,qb,T.Q,T.K,T.V,T.O,T.LC+(long)bh*SEQ,T.KMAX+bh*2,lds);
  }
}
#undef SBAR
#undef WAIT_BAR
}

#define LAS __attribute__((address_space(3)))
#define GASP(T, p) ((__attribute__((address_space(1))) T*)(p))
namespace yk {
using pg8::f32x4; using pg8::u32x4; using pg8::bf16_t; using pg8::Unit; using pg8::BM; using pg8::HALF; using pg8::cvt_pk_bf16;
typedef unsigned u32x2 __attribute__((ext_vector_type(2)));
constexpr int M = 32768, D = 1024, SEQ = 4096, NBATCH = 8, NH = 16, HD = 64, FF = 2816, FF2 = 5632, NG = 64, NP = 64;
constexpr float EPS = 1e-6f;
constexpr float LOG2E = 1.4426950408889634f;
constexpr float C2 = 0.125f * LOG2E;
constexpr int FFM_TILES = 130;

constexpr size_t MiB = 1u << 20;
constexpr size_t WS_PART = 1 * MiB;
constexpr size_t WS_S5LB = 6 * MiB;
constexpr size_t WS_S5BB = 6 * MiB + 65536;
constexpr size_t WS_S5D = 7 * MiB + 512 * 1024;
constexpr size_t WS_WKV = 8 * MiB;
constexpr size_t WS_WQ = 12 * MiB;
constexpr size_t WS_WO = 16 * MiB;
constexpr size_t WS_WFI23 = 20 * MiB;
constexpr size_t WS_WFO23 = 42 * MiB;
constexpr size_t WS_WF = 53 * MiB;
constexpr size_t WS_LC = 54 * MiB;
constexpr size_t WS_TOT = 56 * MiB;
constexpr size_t WS_HB = 58 * MiB;
constexpr size_t WS_BUFA = 124 * MiB;
constexpr size_t WS_K = 189 * MiB, WS_V = 253 * MiB;
constexpr size_t WS_WGLU = WS_K;
constexpr size_t WS_WFI01 = WS_K + 8 * MiB;
constexpr size_t WS_WFO01 = WS_K + 30 * MiB;
constexpr size_t WS_S5W = WS_K + 44 * MiB;
constexpr size_t WS_S5V = WS_K + 60 * MiB;
constexpr size_t WS_S5K = WS_K + 76 * MiB;
constexpr size_t WS_S5A = WS_K + 78 * MiB;
constexpr size_t WS_ACT = 318 * MiB;
constexpr size_t WS_HALO = 496 * MiB;
constexpr size_t WS_END = 502 * MiB;

constexpr int RING_BYTES = 131072;
constexpr int XCH_OFF = RING_BYTES;
constexpr int LDS_BYTES = 147456;

__device__ __forceinline__ float wave_sum(float v) {
#pragma unroll
    for (int o = 1; o < 64; o <<= 1) v += __shfl_xor(v, o);
    return v;
}
__device__ __forceinline__ unsigned f2bf(float f) { unsigned u = __builtin_bit_cast(unsigned, f); return (u + 0x7fffu + ((u >> 16) & 1u)) >> 16; }
__device__ __forceinline__ unsigned pk2(float lo, float hi) { return f2bf(lo) | (f2bf(hi) << 16); }
__device__ __forceinline__ float bf2f(unsigned short b) { return __builtin_bit_cast(float, (unsigned)b << 16); }

__device__ __forceinline__ float rstd_from_part(const float* part, int row, int fq) {
    const f32x4 a = *GASP(const f32x4, part + (size_t)row * 32 + 4 * fq);
    const f32x4 b = *GASP(const f32x4, part + (size_t)row * 32 + 16 + 4 * fq);
    float s = ((a[0] + a[1]) + (a[2] + a[3])) + ((b[0] + b[1]) + (b[2] + b[3]));
    s += __shfl_xor(s, 16); s += __shfl_xor(s, 32);
    return rsqrtf(s * (1.0f / D) + EPS);
}
__device__ __forceinline__ float rstd_row_wave(const float* part, int row, int lane) {
    float s = (lane < 32) ? part[(size_t)row * 32 + lane] : 0.f;
    s = wave_sum(s);
    return rsqrtf(s * (1.0f / D) + EPS);
}

struct EpiRes {
    static constexpr bool PERM = true, AFTER_DRAIN = false;
    bf16_t* hb; float* part;
    __device__ __forceinline__ void operator()(const f32x4 (&acc)[2][2][4][2], const Unit& u, int wr, int wc, int fr_in, int fq_in) const {
        int ln_ = threadIdx.x & 63; asm volatile("" : "+v"(ln_)); const int fr = ln_ & 15, fq = ln_ >> 4; (void)fr_in; (void)fq_in;
        const int col0 = u.pn * BM + wc * 32 + 8 * fq;
#pragma unroll
        for (int ai = 0; ai < 2; ++ai)
#pragma unroll
            for (int m = 0; m < 4; ++m) {
                const int row = u.pm * BM + ai * HALF + wr * 64 + m * 16 + fr; float ss = 0.f;
#pragma unroll
                for (int bj = 0; bj < 2; ++bj) {
                    const size_t off = (size_t)row * D + col0 + bj * HALF;
                    const u32x4 hw = *GASP(const u32x4, hb + off);
                    f32x4 a, b;
                    a[0] = __builtin_bit_cast(float, hw.x << 16); a[1] = __builtin_bit_cast(float, hw.x & 0xffff0000u); a[2] = __builtin_bit_cast(float, hw.y << 16); a[3] = __builtin_bit_cast(float, hw.y & 0xffff0000u);
                    b[0] = __builtin_bit_cast(float, hw.z << 16); b[1] = __builtin_bit_cast(float, hw.z & 0xffff0000u); b[2] = __builtin_bit_cast(float, hw.w << 16); b[3] = __builtin_bit_cast(float, hw.w & 0xffff0000u);
                    a += acc[ai][bj][m][0]; b += acc[ai][bj][m][1];
                    u32x4 w; w.x = cvt_pk_bf16(a[0], a[1]); w.y = cvt_pk_bf16(a[2], a[3]); w.z = cvt_pk_bf16(b[0], b[1]); w.w = cvt_pk_bf16(b[2], b[3]);
                    *GASP(u32x4, hb + off) = w;
                    ss += (a[0] * a[0] + a[1] * a[1]) + (a[2] * a[2] + a[3] * a[3]) + (b[0] * b[0] + b[1] * b[1]) + (b[2] * b[2] + b[3] * b[3]);
                }
                ss += __shfl_xor(ss, 16); ss += __shfl_xor(ss, 32);
                if (fq == 0) *GASP(float, part + (size_t)row * 32 + u.pn * 4 + wc) = ss;
                else if (fq == 1) *GASP(float, part + (size_t)row * 32 + 16 + u.pn * 4 + wc) = 0.f;
            }
    }
};
struct EpiGlu {
    static constexpr bool PERM = true, AFTER_DRAIN = false;
    const float* hin32; bf16_t* hb; float* part;
    __device__ __forceinline__ void operator()(const f32x4 (&acc)[2][2][4][2], const Unit& u, int wr, int wc, int fr_in, int fq_in) const {
        int ln_ = threadIdx.x & 63; asm volatile("" : "+v"(ln_)); const int fr = ln_ & 15, fq = ln_ >> 4; (void)fr_in; (void)fq_in;
        const int col0 = u.pn * 128 + wc * 32 + 8 * fq;
#pragma unroll
        for (int ai = 0; ai < 2; ++ai)
#pragma unroll
            for (int m = 0; m < 4; ++m) {
                const int row = u.pm * BM + ai * HALF + wr * 64 + m * 16 + fr; float ss = 0.f;
                const size_t off = (size_t)row * D + col0;
                f32x4 v[2];
                if (hin32) { v[0] = *GASP(const f32x4, hin32 + off); v[1] = *GASP(const f32x4, hin32 + off + 4); }
                else { const u32x4 hw = *GASP(const u32x4, hb + off);
                    v[0][0] = __builtin_bit_cast(float, hw.x << 16); v[0][1] = __builtin_bit_cast(float, hw.x & 0xffff0000u); v[0][2] = __builtin_bit_cast(float, hw.y << 16); v[0][3] = __builtin_bit_cast(float, hw.y & 0xffff0000u);
                    v[1][0] = __builtin_bit_cast(float, hw.z << 16); v[1][1] = __builtin_bit_cast(float, hw.z & 0xffff0000u); v[1][2] = __builtin_bit_cast(float, hw.w << 16); v[1][3] = __builtin_bit_cast(float, hw.w & 0xffff0000u); }
#pragma unroll
                for (int n = 0; n < 2; ++n) {
                    const f32x4 a = acc[ai][0][m][n], g = acc[ai][1][m][n];
                    f32x4 x = v[n];
#pragma unroll
                    for (int e = 0; e < 4; ++e) x[e] += a[e] * __builtin_amdgcn_rcpf(1.0f + __expf(-g[e]));
                    v[n] = x;
                    ss += (x[0] * x[0] + x[1] * x[1]) + (x[2] * x[2] + x[3] * x[3]);
                }
                u32x4 w; w.x = cvt_pk_bf16(v[0][0], v[0][1]); w.y = cvt_pk_bf16(v[0][2], v[0][3]); w.z = cvt_pk_bf16(v[1][0], v[1][1]); w.w = cvt_pk_bf16(v[1][2], v[1][3]);
                *GASP(u32x4, hb + off) = w;
                ss += __shfl_xor(ss, 16); ss += __shfl_xor(ss, 32);
                if (fq == 0) *GASP(float, part + (size_t)row * 32 + u.pn * 4 + wc) = ss;
            }
    }
};
struct EpiScale {
    static constexpr bool PERM = true, AFTER_DRAIN = false;
    bf16_t* O0; bf16_t* O1; const float* part; float cs; unsigned* kmax;
    __device__ __forceinline__ void operator()(const f32x4 (&acc)[2][2][4][2], const Unit& u, int wr, int wc, int fr_in, int fq_in) const {
        int ln_ = threadIdx.x & 63; asm volatile("" : "+v"(ln_)); const int fr = ln_ & 15, fq = ln_ >> 4; (void)fr_in; (void)fq_in;
        bf16_t* base = (u.pn < 4) ? O0 : O1; const int col0 = (u.pn & 3) * BM + wc * 32 + 8 * fq;
        float km[2] = {0.f, 0.f};
#pragma unroll
        for (int ai = 0; ai < 2; ++ai)
#pragma unroll
            for (int m = 0; m < 4; ++m) {
                const int row = u.pm * BM + ai * HALF + wr * 64 + m * 16 + fr;
                const float r = rstd_from_part(part, row, fq) * cs;
#pragma unroll
                for (int bj = 0; bj < 2; ++bj) {
                    const f32x4 a = acc[ai][bj][m][0] * r, b = acc[ai][bj][m][1] * r;
                    u32x4 w; w.x = cvt_pk_bf16(a[0], a[1]); w.y = cvt_pk_bf16(a[2], a[3]); w.z = cvt_pk_bf16(b[0], b[1]); w.w = cvt_pk_bf16(b[2], b[3]);
                    *GASP(u32x4, base + (size_t)row * D + col0 + bj * HALF) = w;
                    if (kmax) { float ss = (a[0] * a[0] + a[1] * a[1]) + (a[2] * a[2] + a[3] * a[3]) + (b[0] * b[0] + b[1] * b[1]) + (b[2] * b[2] + b[3] * b[3]);
                        ss += __shfl_xor(ss, 16); ss += __shfl_xor(ss, 32); km[bj] = fmaxf(km[bj], ss); }
                }
                asm volatile("" ::: "memory");
            }
        if (kmax && u.pn < 4) {
#pragma unroll
            for (int bj = 0; bj < 2; ++bj) {
                float v = km[bj];
#pragma unroll
                for (int o = 1; o < 16; o <<= 1) v = fmaxf(v, __shfl_xor(v, o));
                v *= 1.02f;
                if (ln_ == 0) { const int b = (u.pm * BM) / SEQ, head = (u.pn & 3) * 4 + 2 * bj + (wc >> 1); atomicMax(kmax + (b * NH + head) * 2 + (wc & 1), __float_as_uint(v)); }
            }
        }
    }
};
template <int CTRL> __device__ __forceinline__ float dpp_mov(float old, float src) {
    return __builtin_bit_cast(float, __builtin_amdgcn_update_dpp(__builtin_bit_cast(int, old), __builtin_bit_cast(int, src), CTRL, 0xf, 0xf, false));
}
template <int CTRL> __device__ __forceinline__ float dpp_all(float src) {
    return __builtin_bit_cast(float, __builtin_amdgcn_update_dpp(0, __builtin_bit_cast(int, src), CTRL, 0xf, 0xf, true));
}
struct EpiConv {
    static constexpr bool PERM = true, AFTER_DRAIN = false;
    unsigned char* wsb; const float* cw; const float* cb; LAS unsigned char* xch; int layer;
    __device__ __forceinline__ void operator()(f32x4 (&acc)[2][2][4][2], const Unit& u, int wr, int wc, int fr_in, int fq_in) const {
        int ln_ = threadIdx.x & 63; asm volatile("" : "+v"(ln_)); const int fr = ln_ & 15, fq = ln_ >> 4; (void)fr_in; (void)fq_in;
        const int trow0 = 256 * u.pm;
        bf16_t* const act = (bf16_t*)(wsb + WS_ACT); const float* const part = (const float*)(wsb + WS_PART); float* const halo = (float*)(wsb + WS_HALO); unsigned* const flags = (unsigned*)(wsb + 16384) + layer * (128 * 22);
#pragma unroll
        for (int ai = 0; ai < 2; ++ai)
#pragma unroll
            for (int m = 0; m < 4; ++m) {
                const int R = trow0 + ai * HALF + wr * 64 + m * 16 + fr;
                const float rs = rstd_from_part(part, R, fq);
#pragma unroll
                for (int bj = 0; bj < 2; ++bj)
#pragma unroll
                    for (int n = 0; n < 2; ++n) acc[ai][bj][m][n] *= rs;
                asm volatile("" ::: "memory");
            }
        if (fr >= 14) {
#pragma unroll
            for (int ai = 0; ai < 2; ++ai) { const int q = 2 * ai + wr;
#pragma unroll
                for (int bj = 0; bj < 2; ++bj)
#pragma unroll
                    for (int n = 0; n < 2; ++n)
                        *(LAS f32x4*)(xch + (size_t)(((q * 2 + (fr - 14)) * 256 + 128 * bj + 32 * wc + 8 * fq + 4 * n) * 4)) = acc[ai][bj][3][n];
            }
            if (wr == 1) {
                float* hp = halo + ((size_t)(u.pm * 22 + u.pn) * 2 + (fr - 14)) * 256 + 32 * wc + 8 * fq;
#pragma unroll
                for (int bj = 0; bj < 2; ++bj)
#pragma unroll
                    for (int n = 0; n < 2; ++n)
#pragma unroll
                        for (int e = 0; e < 4; ++e) __hip_atomic_store(GASP(float, hp + 128 * bj + 4 * n + e), acc[1][bj][3][n][e], __ATOMIC_RELAXED, __HIP_MEMORY_SCOPE_AGENT);
            }
        }
        if (wr == 1) asm volatile("s_waitcnt vmcnt(0)" ::: "memory");
        asm volatile("s_waitcnt lgkmcnt(0)" ::: "memory"); __builtin_amdgcn_s_barrier(); asm volatile("" ::: "memory");
        const bool need = (u.pm & 15) != 0;
        if (wr == 0 && wc == 0) {
            if (fr == 0 && fq == 0) {
                __hip_atomic_store(flags + u.pm * 22 + u.pn, 1u, __ATOMIC_RELAXED, __HIP_MEMORY_SCOPE_AGENT);
                if (need) { unsigned sp = 0u; while (__hip_atomic_load(flags + (u.pm - 1) * 22 + u.pn, __ATOMIC_RELAXED, __HIP_MEMORY_SCOPE_AGENT) == 0u) { __builtin_amdgcn_s_sleep(2); if (++sp > (1u << 22)) break; } }
                __builtin_amdgcn_fence(__ATOMIC_ACQUIRE, "agent");
            }
        }
        asm volatile("s_waitcnt lgkmcnt(0)" ::: "memory"); __builtin_amdgcn_s_barrier(); asm volatile("" ::: "memory");
#pragma unroll
        for (int n = 0; n < 2; ++n) {
            int fq2 = fq, fr2 = fr; asm volatile("" : "+v"(fq2), "+v"(fr2));
            const int jc = u.pn * 128 + 32 * wc + 8 * fq2 + 4 * n;
            const f32x4 g0 = *GASP(const f32x4, cw + jc), g1 = *GASP(const f32x4, cw + FF2 + jc), g2 = *GASP(const f32x4, cw + 2 * FF2 + jc), gb = *GASP(const f32x4, cb + jc);
            const f32x4 u0 = *GASP(const f32x4, cw + FF + jc), u1 = *GASP(const f32x4, cw + FF2 + FF + jc), u2 = *GASP(const f32x4, cw + 2 * FF2 + FF + jc), ub = *GASP(const f32x4, cb + FF + jc);
#pragma unroll
            for (int ai = 0; ai < 2; ++ai) {
                const int q = 2 * ai + wr;
                f32x4 vbg = (f32x4){0.f, 0.f, 0.f, 0.f}, vbu = vbg;
                if (fr2 >= 14) {
                    if (q >= 1) {
                        vbg = *(const LAS f32x4*)(xch + (size_t)((((q - 1) * 2 + (fr2 - 14)) * 256 + 32 * wc + 8 * fq2 + 4 * n) * 4));
                        vbu = *(const LAS f32x4*)(xch + (size_t)((((q - 1) * 2 + (fr2 - 14)) * 256 + 128 + 32 * wc + 8 * fq2 + 4 * n) * 4));
                    } else if (need) {
                        const float* hp = halo + ((size_t)((u.pm - 1) * 22 + u.pn) * 2 + (fr2 - 14)) * 256 + 32 * wc + 8 * fq2 + 4 * n;
#pragma unroll
                        for (int e = 0; e < 4; ++e) { vbg[e] = __hip_atomic_load(GASP(const float, hp + e), __ATOMIC_RELAXED, __HIP_MEMORY_SCOPE_AGENT); vbu[e] = __hip_atomic_load(GASP(const float, hp + 128 + e), __ATOMIC_RELAXED, __HIP_MEMORY_SCOPE_AGENT); }
                    }
                }
#pragma unroll
                for (int m = 0; m < 4; ++m) {
                    const int R = trow0 + ai * HALF + wr * 64 + m * 16 + fr2;
                    const f32x4 cg = acc[ai][0][m][n], cu = acc[ai][1][m][n];
                    const f32x4 pg = (m == 0) ? vbg : acc[ai][0][m == 0 ? 0 : m - 1][n], pu = (m == 0) ? vbu : acc[ai][1][m == 0 ? 0 : m - 1][n];
                    float o[4];
#pragma unroll
                    for (int e = 0; e < 4; ++e) {
                        const float g1p = dpp_mov<0x111>(dpp_all<0x121>(pg[e]), cg[e]);
                        const float g2p = dpp_mov<0x112>(dpp_all<0x122>(pg[e]), cg[e]);
                        const float u1p = dpp_mov<0x111>(dpp_all<0x121>(pu[e]), cu[e]);
                        const float u2p = dpp_mov<0x112>(dpp_all<0x122>(pu[e]), cu[e]);
                        const float ug = g2[e] * cg[e] + (g1[e] * g1p + (g0[e] * g2p + gb[e]));
                        const float uu = u2[e] * cu[e] + (u1[e] * u1p + (u0[e] * u2p + ub[e]));
                        o[e] = ug * uu * __builtin_amdgcn_rcpf(1.0f + __expf(-ug));
                    }
                    u32x2 w; w.x = cvt_pk_bf16(o[0], o[1]); w.y = cvt_pk_bf16(o[2], o[3]); *GASP(u32x2, act + (size_t)R * FF + jc) = w;
                }
            }
            asm volatile("" ::: "memory");
        }
    }
};

__device__ __forceinline__ void tr_item(const float* W, int ldw, int K, bf16_t* WT, int nblk, int item, int lane, LAS float* scr, int mode, int hoff, const float* gk) {
    const int kb = item / nblk, nb = item % nblk, k0 = 64 * kb, n0 = 64 * nb;
    int sc = n0;
    if (mode == 1) { const int t = n0 >> 8, j = n0 & 255; sc = (j < 128) ? (128 * t + j) : (hoff + 128 * t + j - 128); }
    const int c4 = lane & 15, kq = lane >> 4;
#pragma unroll
    for (int i = 0; i < 16; ++i) { const int kk = 4 * i + kq; f32x4 v = *GASP(const f32x4, W + (size_t)(k0 + kk) * ldw + sc + 4 * c4); if (gk) v = v * *GASP(const float, gk + k0 + kk);
        LAS float* d = scr + kk * 65 + 4 * c4; d[0] = v[0]; d[1] = v[1]; d[2] = v[2]; d[3] = v[3]; }
    asm volatile("s_waitcnt lgkmcnt(0)" ::: "memory");
    const int c = lane & 7;
#pragma unroll
    for (int j = 0; j < 8; ++j) { const int n = (lane >> 3) + 8 * j; const LAS float* s = scr + (8 * c) * 65 + n;
        u32x4 o; o.x = pk2(s[0 * 65], s[1 * 65]); o.y = pk2(s[2 * 65], s[3 * 65]); o.z = pk2(s[4 * 65], s[5 * 65]); o.w = pk2(s[6 * 65], s[7 * 65]);
        *GASP(u32x4, WT + (size_t)(n0 + n) * K + k0 + 8 * c) = o; }
    asm volatile("s_waitcnt lgkmcnt(0)" ::: "memory");
}

struct Args { const float* in[22]; float* out; unsigned char* ws; };

__device__ __forceinline__ float gelu_tanh(float y) {
    const float z = 0.7978845608028654f * (y + 0.044715f * y * y * y);
    const float t = 1.0f - 2.0f * __builtin_amdgcn_rcpf(__expf(2.0f * z) + 1.0f);
    return 0.5f * y * (1.0f + t);
}

__device__ __forceinline__ void s5_simple(const Args& a, int l, const float* h, const float* part, bf16_t* Y, const float* LBt, const float* BBt) {
    int tid_l = threadIdx.x; asm volatile("" : "+v"(tid_l)); const int tid = tid_l, lane = tid & 63, wave = tid >> 6;
    if (wave >= 2) return;
    for (int item = blockIdx.x * 2 + wave; item < NBATCH * NG; item += gridDim.x * 2) {
        const int b = item / NG, g = item % NG, p = lane;
        const float lbre = LBt[((l * NG + g) * NP + p) * 2], lbim = LBt[((l * NG + g) * NP + p) * 2 + 1];
        float bbre[16], bbim[16], cre[16], cim[16], gm[16], dsk[16];
        const float* bbt = BBt + ((size_t)(l * NG + g) * NP + p) * 32;
#pragma unroll
        for (int hh = 0; hh < 16; ++hh) {
            bbre[hh] = bbt[hh]; bbim[hh] = bbt[16 + hh];
            cre[hh] = a.in[8][((size_t)(l * NG + g) * 16 + hh) * NP + p]; cim[hh] = a.in[9][((size_t)(l * NG + g) * 16 + hh) * NP + p];
            gm[hh] = a.in[1][l * D + 16 * g + hh]; dsk[hh] = a.in[10][l * D + 16 * g + hh];
        }
        float sre = 0.f, sim = 0.f;
        const size_t row0 = (size_t)b * SEQ;
        for (int t = 0; t < SEQ; ++t) {
            const f32x4* hp = (const f32x4*)(h + (row0 + t) * D + 16 * g);
            const f32x4 cv[4] = {hp[0], hp[1], hp[2], hp[3]}; const float cp = (lane < 32) ? part[(row0 + t) * 32 + lane] : 0.f;
            const float rstd = rsqrtf(wave_sum(cp) * (1.0f / D) + EPS);
            float uu[16];
#pragma unroll
            for (int hh = 0; hh < 16; ++hh) uu[hh] = cv[hh >> 2][hh & 3] * rstd * gm[hh];
            float bure = 0.f, buim = 0.f;
#pragma unroll
            for (int hh = 0; hh < 16; ++hh) { bure += bbre[hh] * uu[hh]; buim += bbim[hh] * uu[hh]; }
            const float nre = lbre * sre - lbim * sim + bure, nim = lbre * sim + lbim * sre + buim;
            sre = nre; sim = nim;
            float my = 0.f;
#pragma unroll
            for (int hh = 0; hh < 16; ++hh) {
                float v = cre[hh] * sre - cim[hh] * sim;
                v = wave_sum(v) + dsk[hh] * uu[hh];
                my = (lane == hh) ? v : my;
            }
            if (lane < 16) Y[(row0 + t) * D + 16 * g + lane] = (bf16_t)f2bf(gelu_tanh(my));
        }
    }
}


typedef short s16x8 __attribute__((ext_vector_type(8)));
typedef float f32x16 __attribute__((ext_vector_type(16)));
typedef float f32x2 __attribute__((ext_vector_type(2)));
__device__ __forceinline__ void lpow(double lr, double li, double dt, int n, double& re, double& im) {
    const double mag = exp(lr * dt * (double)n), ang = li * dt * (double)n; re = mag * cos(ang); im = mag * sin(ang);
}
__device__ __forceinline__ void cpowf(float br, float bi, int n, float& rr, float& ri) {
    float xr = br, xi = bi; rr = 1.f; ri = 0.f;
#pragma unroll 1
    while (n) { if (n & 1) { const float t = rr * xr - ri * xi; ri = rr * xi + ri * xr; rr = t; } const float t2 = xr * xr - xi * xi; xi = 2.f * xr * xi; xr = t2; n >>= 1; }
}
constexpr int S5_U = 0, S5_USTR = 1040, S5_K = 66560, S5_S = S5_K + 16384, S5_SSTR = 272, S5_L = S5_S + 64 * S5_SSTR, S5_LSTR = 528, S5_R = S5_L + 64 * S5_LSTR, S5_LDS_END = S5_R + 8192;
static_assert(S5_LDS_END <= LDS_BYTES, "S5 LDS map");
__device__ __forceinline__ void s5_mfma(const Args& a, int l, const float* h, const bf16_t* hbf, const float* part, bf16_t* Y, const unsigned char* ws, LAS unsigned char* lds) {
    int tid_l = threadIdx.x; asm volatile("" : "+v"(tid_l)); const int tid = tid_l, lane = tid & 63, wave = __builtin_amdgcn_readfirstlane(tid >> 6);
    const int n32 = lane & 31, kh = lane >> 5, qd = tid & 3;
    for (int item = blockIdx.x; item < NBATCH * NG; item += gridDim.x) {
        int g = item & 63, b = item >> 6;
        if (gridDim.x == 256) { const int c = blockIdx.x, x = c & 7, idx = c >> 3; g = 8 * x + (idx & 7); b = (idx >> 3) + 4 * (item >> 8); }
        const int lg = l * NG + g;
        const __attribute__((address_space(1))) s16x8* Wt = GASP(const s16x8, ws + WS_S5W) + (size_t)lg * (4 * 32 * 64);
        const __attribute__((address_space(1))) s16x8* Vt = GASP(const s16x8, ws + WS_S5V) + (size_t)lg * (16 * 8 * 64);
        const f32x4 gm = *GASP(const f32x4, a.in[1] + l * D + 16 * g + 4 * qd);
        float sre = 0.f, sim = 0.f, a32r = 0.f, a32i = 0.f;
        if (tid < 64) { const float* ap = (const float*)(ws + WS_S5A) + (size_t)(lg * 64 + tid) * 2; a32r = ap[0]; a32i = ap[1]; }
        for (int sg = 0; sg < 2; ++sg) {
            const size_t row0 = (size_t)b * SEQ + sg * 2048;
            __syncthreads();
            if (sg == 0) {
                const __attribute__((address_space(1))) u32x4* kp = GASP(const u32x4, ws + WS_S5K) + (size_t)lg * 1024;
                *(LAS u32x4*)(lds + S5_K + tid * 16) = kp[tid]; *(LAS u32x4*)(lds + S5_K + 8192 + tid * 16) = kp[512 + tid];
            }
            s16x8 apre[16];
            { const __attribute__((address_space(1))) s16x8* wp0 = Wt + (size_t)((wave >> 1) * 32) * 64 + lane;
#pragma unroll
              for (int j = 0; j < 16; ++j) apre[j] = wp0[j * 64]; }
#pragma unroll 8
            for (int i = 0; i < 16; ++i) {
                const int idx = tid + 512 * i, tt = idx >> 2;
                f32x4 v;
                if (h) v = *GASP(const f32x4, h + (row0 + tt) * D + 16 * g + 4 * qd);
                else { const u32x2 hw = *GASP(const u32x2, hbf + (row0 + tt) * D + 16 * g + 4 * qd);
                    v[0] = __builtin_bit_cast(float, hw.x << 16); v[1] = __builtin_bit_cast(float, hw.x & 0xffff0000u); v[2] = __builtin_bit_cast(float, hw.y << 16); v[3] = __builtin_bit_cast(float, hw.y & 0xffff0000u); }
                const f32x4 p0 = *GASP(const f32x4, part + (row0 + tt) * 32 + 8 * qd), p1 = *GASP(const f32x4, part + (row0 + tt) * 32 + 8 * qd + 4);
                float sm = ((p0[0] + p0[1]) + (p0[2] + p0[3])) + ((p1[0] + p1[1]) + (p1[2] + p1[3]));
                sm += __shfl_xor(sm, 1); sm += __shfl_xor(sm, 2);
                const float r = rsqrtf(sm * (1.0f / D) + EPS);
                u32x2 w; w.x = cvt_pk_bf16(v[0] * r * gm[0], v[1] * r * gm[1]); w.y = cvt_pk_bf16(v[2] * r * gm[2], v[3] * r * gm[3]);
                *(LAS u32x2*)(lds + S5_U + (tt >> 5) * S5_USTR + (tt & 31) * 32 + qd * 8) = w;
            }
            __syncthreads();
            {
                const int mt = wave >> 1, nt = wave & 1;
                f32x16 acc = {}, accb = {};
                const __attribute__((address_space(1))) s16x8* wp = Wt + (size_t)(mt * 32) * 64 + lane;
                const LAS unsigned char* up = lds + S5_U + (32 * nt + n32) * S5_USTR + kh * 16;
                s16x8 ap2[16];
#pragma unroll
                for (int j = 0; j < 16; ++j) ap2[j] = wp[(16 + j) * 64];
#pragma unroll
                for (int j = 0; j < 16; j += 2) {
                    const s16x8 B0 = *(const LAS s16x8*)(up + j * 32), B1 = *(const LAS s16x8*)(up + (j + 1) * 32);
                    acc = __builtin_amdgcn_mfma_f32_32x32x16_bf16(apre[j], B0, acc, 0, 0, 0);
                    accb = __builtin_amdgcn_mfma_f32_32x32x16_bf16(apre[j + 1], B1, accb, 0, 0, 0);
                }
#pragma unroll
                for (int j = 0; j < 16; j += 2) {
                    const s16x8 B0 = *(const LAS s16x8*)(up + (16 + j) * 32), B1 = *(const LAS s16x8*)(up + (17 + j) * 32);
                    acc = __builtin_amdgcn_mfma_f32_32x32x16_bf16(ap2[j], B0, acc, 0, 0, 0);
                    accb = __builtin_amdgcn_mfma_f32_32x32x16_bf16(ap2[j + 1], B1, accb, 0, 0, 0);
                }
                acc += accb;
#pragma unroll
                for (int q4 = 0; q4 < 4; ++q4)
                    *(LAS f32x4*)(lds + S5_L + (32 * nt + n32) * S5_LSTR + (32 * mt + 8 * q4 + 4 * kh) * 4) = (f32x4){acc[4 * q4], acc[4 * q4 + 1], acc[4 * q4 + 2], acc[4 * q4 + 3]};
            }
            __syncthreads();
            if (tid < 64) {
#pragma unroll 1
                for (int c0 = 0; c0 < 64; c0 += 32) {
                    f32x2 lv[32];
#pragma unroll
                    for (int c = 0; c < 32; ++c) lv[c] = *(const LAS f32x2*)(lds + S5_L + (c0 + c) * S5_LSTR + tid * 8);
#pragma unroll
                    for (int c = 0; c < 32; ++c) {
                        *(LAS unsigned*)(lds + S5_S + (c0 + c) * S5_SSTR + tid * 4) = cvt_pk_bf16(sre, sim);
                        const float nr = a32r * sre - a32i * sim + lv[c][0], ni = a32r * sim + a32i * sre + lv[c][1];
                        sre = nr; sim = ni;
                    }
                }
            }
            __syncthreads();
            {
                const int nt = wave & 1, dtl = n32 >> 4, hp = n32 & 15;
                const LAS unsigned char* up = lds + S5_U + (32 * nt + n32) * S5_USTR + kh * 16;
                const LAS unsigned char* sp = lds + S5_S + (32 * nt + n32) * S5_SSTR + kh * 16;
                const LAS unsigned char* kp = lds + S5_K + hp * 32 + kh * 16;
                const int w4 = wave >> 1;
                f32x16 acc4[4] = {};
#pragma unroll 4
                for (int ks = 0; ks < 8; ++ks) {
                    const s16x8 B = *(const LAS s16x8*)(sp + ks * 32);
#pragma unroll
                    for (int i4 = 0; i4 < 4; ++i4) {
                        const s16x8 A = *(Vt + (size_t)((w4 + 4 * i4) * 8 + ks) * 64 + lane);
                        acc4[i4] = __builtin_amdgcn_mfma_f32_32x32x16_bf16(A, B, acc4[i4], 0, 0, 0);
                    }
                }
                for (int j = 0; j <= 2 * (w4 + 12) + 1; ++j) {
                    const s16x8 B = *(const LAS s16x8*)(up + j * 32);
#pragma unroll
                    for (int i4 = 0; i4 < 4; ++i4) {
                        const int mt = w4 + 4 * i4;
                        if (j <= 2 * mt + 1) {
                            const int lag = 2 * mt + dtl - j, lagc = lag < 0 ? 0 : lag;
                            s16x8 A = *(const LAS s16x8*)(kp + lagc * 512);
                            if (lag < 0) A = (s16x8){0, 0, 0, 0, 0, 0, 0, 0};
                            acc4[i4] = __builtin_amdgcn_mfma_f32_32x32x16_bf16(A, B, acc4[i4], 0, 0, 0);
                        }
                    }
                }
#pragma unroll
                for (int i4 = 0; i4 < 4; ++i4) {
                    const int mt = w4 + 4 * i4;
#pragma unroll
                    for (int q4 = 0; q4 < 4; ++q4) {
                        const int tok = (32 * nt + n32) * 32 + 2 * mt + (q4 >> 1), h0 = 8 * (q4 & 1) + 4 * kh;
                        u32x2 w; w.x = cvt_pk_bf16(gelu_tanh(acc4[i4][4 * q4]), gelu_tanh(acc4[i4][4 * q4 + 1])); w.y = cvt_pk_bf16(gelu_tanh(acc4[i4][4 * q4 + 2]), gelu_tanh(acc4[i4][4 * q4 + 3]));
                        *GASP(u32x2, Y + (row0 + tok) * D + 16 * g + h0) = w;
                    }
                }
            }
        }
    }
    __syncthreads();
}

__device__ __forceinline__ void f_phase(const Args& a, const float* h, const float* part, const float* WF, float* LC, float* TOT, LAS unsigned char* lds) {
    int tid_l = threadIdx.x; asm volatile("" : "+v"(tid_l)); const int tid = tid_l, lane = tid & 63, wave = tid >> 6;
    LAS float* ls = (LAS float*)lds;
    for (int item = blockIdx.x; item < M / 256; item += gridDim.x) {
        __syncthreads();
        const int b = item / 16, ch = item % 16;
        for (int tl = wave * 32; tl < wave * 32 + 32; ++tl) {
            const size_t row = (size_t)item * 256 + tl;
            float accv[16];
#pragma unroll
            for (int hh = 0; hh < 16; ++hh) accv[hh] = 0.f;
#pragma unroll 2
            for (int kk = 0; kk < 16; ++kk) {
                const int k = kk * 64 + lane; const float hv = h[row * D + k];
                const f32x4* wp = (const f32x4*)(WF + (size_t)k * 16);
                const f32x4 w0 = wp[0], w1 = wp[1], w2 = wp[2], w3 = wp[3];
#pragma unroll
                for (int e = 0; e < 4; ++e) { accv[e] += hv * w0[e]; accv[4 + e] += hv * w1[e]; accv[8 + e] += hv * w2[e]; accv[12 + e] += hv * w3[e]; }
            }
            const float rstd = rstd_row_wave(part, (int)row, lane);
            float mine = 0.f;
#pragma unroll
            for (int hh = 0; hh < 16; ++hh) { const float v = wave_sum(accv[hh]); mine = (lane == hh) ? v : mine; }
            if (lane < 16) {
                const float x = mine * rstd + a.in[14][lane];
                const float lsg = fminf(x, 0.f) - log1pf(__expf(-fabsf(x)));
                ls[tl * 16 + lane] = lsg;
            }
        }
        __syncthreads();
        if (tid < 16) {
            float c = 0.f; float* lc = LC + ((size_t)(b * NH + tid)) * SEQ + ch * 256;
            for (int t = 0; t < 256; ++t) { c += ls[t * 16 + tid]; lc[t] = c; }
            TOT[(b * NH + tid) * 16 + ch] = c;
        }
    }
    __syncthreads();
}


__device__ __forceinline__ void f_phase2(const Args& a, const bf16_t* HB, const float* part, const bf16_t* WFb, float* LC, float* TOT, LAS unsigned char* lds) {
    int tid_l = threadIdx.x; asm volatile("" : "+v"(tid_l)); const int tid = tid_l, lane = tid & 63, wave = __builtin_amdgcn_readfirstlane(tid >> 6);
    const int n32 = lane & 31, kh = lane >> 5;
    LAS float* ls = (LAS float*)lds;
    LAS float* rs = ls + 128 * 16;
    LAS float* seg = rs + 128;
    for (int item = blockIdx.x; item < M / 128; item += gridDim.x) {
        __syncthreads();
        const int b = item >> 5, ch = item & 31; const size_t row0 = (size_t)item * 128;
#pragma unroll
        for (int i = 0; i < 2; ++i) {
            const int idx = tid + 512 * i, r = idx >> 3, p8 = idx & 7;
            const f32x4 v = *(const f32x4*)(part + (row0 + r) * 32 + 4 * p8);
            float sm = (v[0] + v[1]) + (v[2] + v[3]);
            sm += __shfl_xor(sm, 1); sm += __shfl_xor(sm, 2); sm += __shfl_xor(sm, 4);
            if (p8 == 0) rs[r] = rsqrtf(sm * (1.0f / D) + EPS);
        }
        f32x16 acc = {};
        if (wave < 4) {
            const __attribute__((address_space(1))) s16x8* ap = GASP(const s16x8, HB + (row0 + 32 * wave + n32) * D + kh * 8);
            const __attribute__((address_space(1))) s16x8* bp = GASP(const s16x8, WFb + (size_t)n32 * D + kh * 8);
#pragma unroll 16
            for (int ks = 0; ks < 64; ++ks) acc = __builtin_amdgcn_mfma_f32_32x32x16_bf16(ap[ks * 2], bp[ks * 2], acc, 0, 0, 0);
        }
        __syncthreads();
        if (wave < 4 && n32 < 16) {
            const float bf = a.in[14][n32];
#pragma unroll
            for (int i = 0; i < 16; ++i) {
                const int tl = 32 * wave + (i & 3) + 8 * (i >> 2) + 4 * kh;
                const float x = acc[i] * rs[tl] + bf;
                ls[tl * 16 + n32] = fminf(x, 0.f) - log1pf(__expf(-fabsf(x)));
            }
        }
        __syncthreads();
        const int hd = tid & 15, sgm = tid >> 4;
        float v4[4], sm = 0.f;
#pragma unroll
        for (int e = 0; e < 4; ++e) { v4[e] = ls[(4 * sgm + e) * 16 + hd]; sm += v4[e]; }
        seg[sgm * 16 + hd] = sm;
        __syncthreads();
        float c = 0.f;
#pragma unroll
        for (int s2 = 0; s2 < 32; ++s2) { const float t = seg[s2 * 16 + hd]; c += (s2 < sgm) ? t : 0.f; }
        float* lc = LC + ((size_t)(b * NH + hd)) * SEQ + ch * 128 + 4 * sgm;
        f32x4 o0;
        c += v4[0]; o0[0] = c; c += v4[1]; o0[1] = c; c += v4[2]; o0[2] = c; c += v4[3]; o0[3] = c;
        *GASP(f32x4, lc) = o0;
        if (sgm == 31) *GASP(float, TOT + (b * NH + hd) * 32 + ch) = c;
    }
    __syncthreads();
}

__device__ __forceinline__ void attn_simple(const bf16_t* Q, const bf16_t* K, const bf16_t* V, bf16_t* O, const float* LC, const float* TOT, LAS unsigned char* lds) {
    int tid_l = threadIdx.x; asm volatile("" : "+v"(tid_l)); const int tid = tid_l;
    LAS float* Kt = (LAS float*)lds;
    LAS float* Vt = Kt + 64 * 64;
    LAS float* bias = Vt + 64 * 64;
    LAS float* offs = bias + 64;
    const int nunits = NBATCH * NH * 8;
    for (int ui = blockIdx.x; ui < nunits; ui += gridDim.x) {
        const int slot = ui / gridDim.x;
        int bh, qb;
        if (gridDim.x == 256) { const int v = blockIdx.x; bh = v >> 1; const int half = v & 1, s = slot & 3; qb = (s & 1) ? (8 - s - half) : (s + half); }
        else { bh = ui >> 3; qb = ui & 7; }
        const int b = bh / NH, hd = bh % NH;
        const int i = qb * 512 + tid;
        __syncthreads();
        if (tid == 0) { float c = 0.f; for (int cc = 0; cc < 16; ++cc) { offs[cc] = c; c += TOT[bh * 16 + cc]; } }
        float q[64], o[64];
        {
            const u32x4* qp = (const u32x4*)(Q + ((size_t)b * SEQ + i) * D + hd * HD);
#pragma unroll
            for (int c8 = 0; c8 < 8; ++c8) { const u32x4 w = qp[c8];
#pragma unroll
                for (int e = 0; e < 4; ++e) { q[c8 * 8 + 2 * e] = __builtin_bit_cast(float, w[e] << 16); q[c8 * 8 + 2 * e + 1] = __builtin_bit_cast(float, w[e] & 0xffff0000u); } }
        }
#pragma unroll
        for (int d = 0; d < 64; ++d) o[d] = 0.f;
        float mx = -1e30f, lsum = 0.f;
        const int ntiles = (qb * 512 + 512) / 64;
        for (int jt = 0; jt < ntiles; ++jt) {
            __syncthreads();
            {
                const int r = tid >> 3, c8 = tid & 7; const size_t src = ((size_t)b * SEQ + jt * 64 + r) * D + hd * HD + c8 * 8;
                const u32x4 kw = *(const u32x4*)(K + src), vw = *(const u32x4*)(V + src);
#pragma unroll
                for (int e = 0; e < 4; ++e) {
                    Kt[r * 64 + c8 * 8 + 2 * e] = __builtin_bit_cast(float, kw[e] << 16); Kt[r * 64 + c8 * 8 + 2 * e + 1] = __builtin_bit_cast(float, kw[e] & 0xffff0000u);
                    Vt[r * 64 + c8 * 8 + 2 * e] = __builtin_bit_cast(float, vw[e] << 16); Vt[r * 64 + c8 * 8 + 2 * e + 1] = __builtin_bit_cast(float, vw[e] & 0xffff0000u);
                }
                if (tid < 64) bias[tid] = -(LC[(size_t)bh * SEQ + jt * 64 + tid] + offs[(jt * 64) >> 8]) * LOG2E;
            }
            __syncthreads();
            int jmax = i - jt * 64; jmax = jmax > 63 ? 63 : jmax;
            for (int j = 0; j <= jmax; ++j) {
                float s = bias[j];
                const LAS f32x4* kr = (const LAS f32x4*)(Kt + j * 64);
#pragma unroll
                for (int d4 = 0; d4 < 16; ++d4) { const f32x4 kv = kr[d4]; s += q[4 * d4] * kv[0] + q[4 * d4 + 1] * kv[1] + q[4 * d4 + 2] * kv[2] + q[4 * d4 + 3] * kv[3]; }
                const float mn = fmaxf(mx, s), corr = exp2f(mx - mn), pp = exp2f(s - mn);
                lsum = lsum * corr + pp; mx = mn;
                const LAS f32x4* vr = (const LAS f32x4*)(Vt + j * 64);
#pragma unroll
                for (int d4 = 0; d4 < 16; ++d4) { const f32x4 vv = vr[d4];
                    o[4 * d4] = o[4 * d4] * corr + pp * vv[0]; o[4 * d4 + 1] = o[4 * d4 + 1] * corr + pp * vv[1]; o[4 * d4 + 2] = o[4 * d4 + 2] * corr + pp * vv[2]; o[4 * d4 + 3] = o[4 * d4 + 3] * corr + pp * vv[3]; }
            }
        }
        const float inv = 1.0f / lsum;
        u32x4* op = (u32x4*)(O + ((size_t)b * SEQ + i) * D + hd * HD);
#pragma unroll
        for (int c8 = 0; c8 < 8; ++c8) { u32x4 w;
#pragma unroll
            for (int e = 0; e < 4; ++e) w[e] = pk2(o[c8 * 8 + 2 * e] * inv, o[c8 * 8 + 2 * e + 1] * inv);
            op[c8] = w; }
    }
    __syncthreads();
}

#define XB_TMO      128
#define XB_XCNT(j)  (256  + 64 * (j))
#define XB_XSUB(j)  (1280 + 64 * (j))
#define XB_XGEN(j)  (2304 + 64 * (j))
#define XB_TOP      3328
#define XB_TOPGEN   3392
#define XCD_BAR_WORDS 3456
#define XB_SPIN_CAP (1u << 18)

__device__ __forceinline__ unsigned xb_ld(unsigned* p)              { return __hip_atomic_load(p, __ATOMIC_RELAXED, __HIP_MEMORY_SCOPE_AGENT); }
__device__ __forceinline__ unsigned xb_add(unsigned* p, unsigned v) { return __hip_atomic_fetch_add(p, v, __ATOMIC_RELAXED, __HIP_MEMORY_SCOPE_AGENT); }
__device__ __forceinline__ unsigned xb_xcc_id() { return (unsigned)__builtin_amdgcn_s_getreg((3 << 11) | 20) & 0xFu; }
#define XB_SPIN(cond, bar) do { unsigned _sp = 0; while (cond) { __builtin_amdgcn_s_sleep(1); \
    if ((++_sp & 255u) == 0u) { if (xb_ld(&(bar)[XB_TMO])) break; if (_sp > XB_SPIN_CAP) { atomicAdd(&(bar)[XB_TMO], 1u); break; } } } } while (0)

struct XcdBarrier {
    unsigned* bar; unsigned x;
    volatile LAS unsigned* st;
};

__device__ __forceinline__ XcdBarrier xcd_barrier_post(unsigned* bar, volatile LAS unsigned* st) {
    XcdBarrier b; b.bar = bar; b.x = xb_xcc_id(); b.st = st;
    if (threadIdx.x == 0) (void)xb_add(&bar[XB_XCNT(b.x)], 1u);
    return b;
}
__device__ __forceinline__ void xcd_barrier_complete(unsigned* bar, unsigned x, unsigned& nloc, unsigned& nx) {
    const unsigned G = gridDim.x * gridDim.y * gridDim.z;
    unsigned sum, cnt, mine, sp = 0u;
    for (;;) {
        sum = 0u; cnt = 0u; mine = 0u;
#pragma unroll
        for (unsigned j = 0; j < 16; ++j) { const unsigned c = xb_ld(&bar[XB_XCNT(j)]); sum += c; cnt += (c > 0u) ? 1u : 0u; mine = (j == x) ? c : mine; }
        if (sum == G) break;
        __builtin_amdgcn_s_sleep(1);
        if ((++sp & 255u) == 0u) { if (xb_ld(&bar[XB_TMO])) break; if (sp > XB_SPIN_CAP) { atomicAdd(&bar[XB_TMO], 1u); break; } }
    }
    nloc = mine > 0u ? mine : 1u; nx = cnt > 0u ? cnt : 1u;
}

__device__ __forceinline__ void xcd_barrier(const XcdBarrier& b) {
    asm volatile("s_waitcnt vmcnt(0)" ::: "memory");
    __syncthreads();
    if (threadIdx.x == 0) {
        unsigned* bar = b.bar;
        __builtin_amdgcn_s_waitcnt(0);
        unsigned nloc = b.st[0], nx = b.st[1];
        if (nloc == 0u) { xcd_barrier_complete(bar, b.x, nloc, nx); b.st[0] = nloc; b.st[1] = nx; }
        const unsigned old = xb_add(&bar[XB_XSUB(b.x)], 1u);
        const unsigned gen = old / nloc;
        if (old + 1u == (gen + 1u) * nloc) {
            __builtin_amdgcn_fence(__ATOMIC_RELEASE, "agent");
            asm volatile("s_waitcnt vmcnt(0)" ::: "memory");
            const unsigned og = xb_add(&bar[XB_TOP], 1u);
            const unsigned tg = og / nx;
            if (og + 1u == (tg + 1u) * nx) xb_add(&bar[XB_TOPGEN], 1u);
            else XB_SPIN(xb_ld(&bar[XB_TOPGEN]) == tg, bar);
            __builtin_amdgcn_fence(__ATOMIC_ACQUIRE, "agent");
            xb_add(&bar[XB_XGEN(b.x)], 1u);
            asm volatile("s_waitcnt vmcnt(0)" ::: "memory");
        } else {
            XB_SPIN(xb_ld(&bar[XB_XGEN(b.x)]) == gen, bar);
            __builtin_amdgcn_fence(__ATOMIC_ACQUIRE, "agent");
            asm volatile("s_waitcnt vmcnt(0)" ::: "memory");
        }
    }
    __syncthreads();
}

__global__ void __launch_bounds__(512, 2) yoco_fwd(Args a) {
    extern __shared__ __attribute__((aligned(16))) unsigned char lds_raw[];
    LAS unsigned char* lds = (LAS unsigned char*)lds_raw;
    cg::grid_group grid = cg::this_grid();
    volatile LAS unsigned* bst = (volatile LAS unsigned*)(lds + (LDS_BYTES - 64));
    if (threadIdx.x == 0) { bst[0] = 0u; bst[1] = 0u; }
    __syncthreads();
    const XcdBarrier xbar = xcd_barrier_post((unsigned*)a.ws, bst);
#ifndef REP_PRO
#define REP_PRO 1
#endif
#ifndef REP_S5
#define REP_S5 1
#endif
#ifndef REP_FI
#define REP_FI 1
#endif
#ifndef REP_AT
#define REP_AT 1
#endif
#ifndef REP_KV
#define REP_KV 1
#endif
#ifndef REP_FOX
#define REP_FOX 0
#endif
#ifndef REP_ANB
#define REP_ANB 0
#endif
#ifndef REP_SYNC
#define REP_SYNC 1
#endif
#define GSYNC() do { for (int rs_ = 0; rs_ < REP_SYNC; ++rs_) xcd_barrier(xbar); } while (0)
#define PHASE_BEGIN unsigned char* ws = a.ws; asm volatile("" : "+s"(ws)); const int G = gridDim.x; (void)G;
#define WSP(T, off) ((T*)(ws + (off)))
#ifndef SK_PRO
    for (int rep_ = 0; rep_ < REP_PRO; ++rep_) {
        PHASE_BEGIN
        int tid_l = threadIdx.x; asm volatile("" : "+v"(tid_l)); const int tid = tid_l, lane = tid & 63, wave = __builtin_amdgcn_readfirstlane(tid >> 6);
        const int gw = blockIdx.x * 8 + wave, NGW = G * 8;
        LAS float* scr = (LAS float*)(lds + wave * 16640);
        constexpr int I_GLU = 16 * 32, I_FI = 16 * 88, I_FO = 44 * 16, I_KV = 16 * 32, I_SQ = 16 * 16;
        constexpr int NITEMS = 2 * I_GLU + 4 * I_FI + 4 * I_FO + I_KV + 4 * I_SQ;
        for (int it = gw; it < NITEMS; it += NGW) {
            int r = it;
            if (r < 2 * I_GLU) { const int l = r / I_GLU; tr_item(a.in[11] + (size_t)l * D * 2048, 2048, D, WSP(bf16_t, WS_WGLU) + (size_t)l * 2048 * D, 32, r % I_GLU, lane, scr, 1, 1024, nullptr); continue; } r -= 2 * I_GLU;
            if (r < 4 * I_FI) { const int l = r / I_FI; bf16_t* dst = (l < 2) ? WSP(bf16_t, WS_WFI01) + (size_t)l * FF2 * D : WSP(bf16_t, WS_WFI23) + (size_t)(l - 2) * FF2 * D;
                tr_item(a.in[17] + (size_t)l * D * FF2, FF2, D, dst, 88, r % I_FI, lane, scr, 1, FF, a.in[2] + l * D); continue; } r -= 4 * I_FI;
            if (r < 4 * I_FO) { const int l = r / I_FO; bf16_t* dst = (l < 2) ? WSP(bf16_t, WS_WFO01) + (size_t)l * D * FF : WSP(bf16_t, WS_WFO23) + (size_t)(l - 2) * D * FF;
                tr_item(a.in[20] + (size_t)l * FF * D, D, FF, dst, 16, r % I_FO, lane, scr, 0, 0, nullptr); continue; } r -= 4 * I_FO;
            if (r < I_KV) { tr_item(a.in[13], 2064, D, WSP(bf16_t, WS_WKV), 32, r, lane, scr, 0, 0, a.in[12]); continue; } r -= I_KV;
            if (r < 2 * I_SQ) { const int j = r / I_SQ; tr_item(a.in[15] + (size_t)j * D * D, D, D, WSP(bf16_t, WS_WQ) + (size_t)j * D * D, 16, r % I_SQ, lane, scr, 0, 0, a.in[1] + (2 + j) * D); continue; } r -= 2 * I_SQ;
            { const int j = r / I_SQ; tr_item(a.in[16] + (size_t)j * D * D, D, D, WSP(bf16_t, WS_WO) + (size_t)j * D * D, 16, r % I_SQ, lane, scr, 0, 0, nullptr); }
        }
        for (int i = blockIdx.x * 512 + tid; i < 32 * D; i += G * 512) { const int hh = i >> 10, k = i & 1023; WSP(bf16_t, WS_WF)[i] = (bf16_t)f2bf(hh < 16 ? a.in[12][k] * a.in[13][(size_t)k * 2064 + 2048 + hh] : 0.f); }
        for (int i = blockIdx.x * 512 + tid; i < 2 * NG * NP; i += G * 512) {
            const int lg = i / NP;
            const double lr = a.in[3][i], li = a.in[4][i], dt = exp((double)a.in[5][lg]);
            double l1r, l1i; lpow(lr, li, dt, 1, l1r, l1i);
            const double den = lr * lr + li * li, nr = l1r - 1.0;
            double* dp = WSP(double, WS_S5D) + (size_t)i * 4;
            dp[0] = l1r; dp[1] = l1i; dp[2] = (nr * lr + l1i * li) / den; dp[3] = (l1i * lr - nr * li) / den;
            double pr, pim; lpow(lr, li, dt, 32, pr, pim); float* ap = WSP(float, WS_S5A) + (size_t)i * 2; ap[0] = (float)pr; ap[1] = (float)pim;
        }
        const float* x = a.in[0]; float* part = WSP(float, WS_PART);
        for (int m = gw; m < M; m += NGW) {
            const __attribute__((address_space(1))) f32x4* xr = GASP(const f32x4, x + (size_t)m * D) + lane; float s = 0.f;
#pragma unroll
            for (int j = 0; j < 4; ++j) { const f32x4 v = xr[64 * j]; s += (v[0] * v[0] + v[1] * v[1]) + (v[2] * v[2] + v[3] * v[3]); }
            s = wave_sum(s);
            if (lane < 32) *GASP(float, part + (size_t)m * 32 + lane) = (lane == 0) ? s : 0.f;
        }
    }
#endif
    grid.sync();
#ifndef SK_PRO
    for (int rep_ = 0; rep_ < REP_PRO; ++rep_) {
        PHASE_BEGIN
        int tid_l = threadIdx.x; asm volatile("" : "+v"(tid_l)); const int tid = tid_l;
        const double* dtab = WSP(double, WS_S5D);
        for (int idx = blockIdx.x * 512 + tid; idx < 2 * 1048576; idx += G * 512) {
            float o8[8];
            if (idx < 1048576) {
                const int ln = idx & 63, j = (idx >> 6) & 31, mt = (idx >> 11) & 3, lg = idx >> 13;
                const int p = 16 * mt + ((ln & 31) >> 1), ri = ln & 1, kh = ln >> 5, pi = lg * 64 + p;
                const double* dp = dtab + (size_t)pi * 4;
                float pr, pim; cpowf((float)dp[0], (float)dp[1], 31 - j, pr, pim);
                const float fr = (float)dp[2], fi = (float)dp[3], gr = pr * fr - pim * fi, gi = pr * fi + pim * fr;
                const f32x4 b0 = *(const f32x4*)(a.in[6] + (size_t)pi * 16 + 8 * kh), b1 = *(const f32x4*)(a.in[6] + (size_t)pi * 16 + 8 * kh + 4);
                const f32x4 c0 = *(const f32x4*)(a.in[7] + (size_t)pi * 16 + 8 * kh), c1 = *(const f32x4*)(a.in[7] + (size_t)pi * 16 + 8 * kh + 4);
#pragma unroll
                for (int e = 0; e < 8; ++e) { const float br = e < 4 ? b0[e & 3] : b1[e & 3], bi = e < 4 ? c0[e & 3] : c1[e & 3]; o8[e] = ri ? (gr * bi + gi * br) : (gr * br - gi * bi); }
            } else {
                const int id2 = idx - 1048576, ln = id2 & 63, ks = (id2 >> 6) & 7, mt = (id2 >> 9) & 15, lg = id2 >> 13;
                const int tl = 2 * mt + ((ln & 31) >> 4), hp = ln & 15, kh = ln >> 5;
                const f32x4 cr4 = *(const f32x4*)(a.in[8] + (size_t)(lg * 16 + hp) * 64 + 8 * ks + 4 * kh), ci4 = *(const f32x4*)(a.in[9] + (size_t)(lg * 16 + hp) * 64 + 8 * ks + 4 * kh);
#pragma unroll
                for (int e2 = 0; e2 < 4; ++e2) {
                    const int pi = lg * 64 + 8 * ks + 4 * kh + e2; const double* dp = dtab + (size_t)pi * 4;
                    float pr, pim; cpowf((float)dp[0], (float)dp[1], tl + 1, pr, pim);
                    o8[2 * e2] = cr4[e2] * pr - ci4[e2] * pim; o8[2 * e2 + 1] = -(cr4[e2] * pim + ci4[e2] * pr);
                }
            }
            u32x4 w; w.x = pk2(o8[0], o8[1]); w.y = pk2(o8[2], o8[3]); w.z = pk2(o8[4], o8[5]); w.w = pk2(o8[6], o8[7]);
            if (idx < 1048576) *(GASP(u32x4, ws + WS_S5W) + idx) = w; else *(GASP(u32x4, ws + WS_S5V) + (idx - 1048576)) = w;
        }
        {
            LAS float* Pw = (LAS float*)lds; LAS float* Bb = Pw + 32 * 64 * 2; LAS float* Cc = Bb + 64 * 16 * 2;
            for (int it2 = blockIdx.x; it2 < 4 * NG; it2 += G) {
                const int lg = it2 >> 1, th = it2 & 1;
                __syncthreads();
#pragma unroll 1
                for (int i = 0; i < 4; ++i) { const int e = tid + 512 * i, tau = e >> 6, p = e & 63; const double* dp = dtab + (size_t)(lg * 64 + p) * 4; float pr, pim; cpowf((float)dp[0], (float)dp[1], tau, pr, pim); Pw[2 * e] = pr; Pw[2 * e + 1] = pim; }
#pragma unroll 1
                for (int i = 0; i < 2; ++i) { const int e = tid + 512 * i, p = e >> 4; const double* dp = dtab + (size_t)(lg * 64 + p) * 4;
                    const float fr = (float)dp[2], fi = (float)dp[3], br = a.in[6][(size_t)lg * 1024 + e], bi = a.in[7][(size_t)lg * 1024 + e];
                    Bb[2 * e] = fr * br - fi * bi; Bb[2 * e + 1] = fr * bi + fi * br;
                    Cc[2 * e] = a.in[8][(size_t)lg * 1024 + e]; Cc[2 * e + 1] = a.in[9][(size_t)lg * 1024 + e]; }
                __syncthreads();
#pragma unroll 1
                for (int i = 0; i < 8; ++i) {
                    const int o = tid + 512 * i + 4096 * th, tau = o >> 8, hp = (o >> 4) & 15, hh = o & 15; float accv = 0.f;
#pragma unroll 8
                    for (int p = 0; p < 64; ++p) {
                        const float cr = Cc[2 * (hp * 64 + p)], ci = Cc[2 * (hp * 64 + p) + 1], wr_ = Pw[2 * (tau * 64 + p)], wi_ = Pw[2 * (tau * 64 + p) + 1];
                        const float cpr = cr * wr_ - ci * wi_, cpi = cr * wi_ + ci * wr_;
                        accv += cpr * Bb[2 * (p * 16 + hh)] - cpi * Bb[2 * (p * 16 + hh) + 1];
                    }
                    if (tau == 0 && hp == hh) accv += a.in[10][(lg >> 6) * D + 16 * (lg & 63) + hp];
                    WSP(bf16_t, WS_S5K)[(size_t)lg * 8192 + o] = (bf16_t)f2bf(accv);
                }
            }
            __syncthreads();
        }
    }
#endif
    GSYNC();

    for (int l = 0; l < 4; ++l) {
        if (l < 2) {
#ifndef SK_S5
#ifdef S5_SIMPLE
            { PHASE_BEGIN s5_simple(a, l, (l == 0) ? a.in[0] : a.out, WSP(float, WS_PART), WSP(bf16_t, WS_BUFA), WSP(float, WS_S5LB), WSP(float, WS_S5BB)); }
#else
            for (int rep_ = 0; rep_ < REP_S5; ++rep_) { PHASE_BEGIN s5_mfma(a, l, (l == 0) ? a.in[0] : (const float*)nullptr, WSP(bf16_t, WS_HB), WSP(float, WS_PART), WSP(bf16_t, WS_BUFA), ws, lds); }
#endif
#endif
            GSYNC();
#ifndef SK_GLU
            {
                PHASE_BEGIN
                pg8::Gemm g{WSP(bf16_t, WS_BUFA), WSP(const bf16_t, WS_WGLU) + (size_t)l * 2048 * D, M, 2048, D, 256}; pg8::StaticOrder S; S.init(M, 2048, G, (int)blockIdx.x);
                EpiGlu E{(l == 0) ? a.in[0] : (const float*)nullptr, WSP(bf16_t, WS_HB), WSP(float, WS_PART)};
                pg8::gemm_phase<EpiGlu, pg8::StaticOrder, true, true>(lds, g, S, E);
            }
#endif
            GSYNC();
        } else {
            const int j = l - 2;
            if (l == 2) {
#ifndef SK_KV
                for (int rep_ = 0; rep_ < REP_KV; ++rep_) {
                    PHASE_BEGIN
                    pg8::Gemm g{WSP(bf16_t, WS_HB), WSP(bf16_t, WS_WKV), M, 2048, D, 256}; pg8::StaticOrder S; S.init(M, 2048, G, (int)blockIdx.x);
                    EpiScale E{WSP(bf16_t, WS_K), WSP(bf16_t, WS_V), WSP(float, WS_PART), 1.0f, WSP(unsigned, 61440)};
                    pg8::gemm_phase<EpiScale, pg8::StaticOrder, true, true>(lds, g, S, E);
                }
#endif
#ifndef SK_F
                for (int rep_ = 0; rep_ < REP_S5; ++rep_) { PHASE_BEGIN f_phase2(a, WSP(bf16_t, WS_HB), WSP(float, WS_PART), WSP(bf16_t, WS_WF), WSP(float, WS_LC), WSP(float, WS_TOT), lds); }
#endif
            }
#ifndef SK_Q
            {
                PHASE_BEGIN
                pg8::Gemm g{WSP(bf16_t, WS_HB), WSP(bf16_t, WS_WQ) + (size_t)j * D * D, M, D, D, 256}; pg8::StaticOrder S; S.init(M, D, G, (int)blockIdx.x);
                EpiScale E{WSP(bf16_t, WS_BUFA), WSP(bf16_t, WS_BUFA), WSP(float, WS_PART), C2, nullptr};
                pg8::gemm_phase<EpiScale, pg8::StaticOrder, true, true>(lds, g, S, E);
            }
#endif
            GSYNC();
#if REP_ANB
            {
                PHASE_BEGIN
                const attn_body::AttnTensors AT{(const attn_body::bf16*)WSP(bf16_t, WS_BUFA), (const attn_body::bf16*)WSP(bf16_t, WS_K), (const attn_body::bf16*)WSP(bf16_t, WS_V), (attn_body::bf16*)(ws + WS_ACT + 64 * MiB), WSP(float, WS_LC), WSP(float, WS_TOT), WSP(float, 61440)};
                const attn_body::StaticOrder AS((int)gridDim.x, (int)blockIdx.x);
                attn_body::attn_phase<attn_body::StaticOrder, 8, false>((char*)lds_raw, AT, AS);
            }
#endif
#ifndef SK_ATTN
#ifdef ATTN_SIMPLE
            { PHASE_BEGIN attn_simple(WSP(bf16_t, WS_BUFA), WSP(bf16_t, WS_K), WSP(bf16_t, WS_V), WSP(bf16_t, WS_BUFA), WSP(float, WS_LC), WSP(float, WS_TOT), lds); }
#else
            for (int rep_ = 0; rep_ < REP_AT; ++rep_) {
                PHASE_BEGIN
                const attn_body::AttnTensors AT{(const attn_body::bf16*)WSP(bf16_t, WS_BUFA), (const attn_body::bf16*)WSP(bf16_t, WS_K), (const attn_body::bf16*)WSP(bf16_t, WS_V), (attn_body::bf16*)WSP(bf16_t, WS_ACT), WSP(float, WS_LC), WSP(float, WS_TOT), WSP(float, 61440)};
                const attn_body::StaticOrder AS((int)gridDim.x, (int)blockIdx.x);
                (void)AS; attn_body::attn_phase_dyn<100>((char*)lds_raw, AT, WSP(unsigned, 62464) + 64 * j);
            }
#endif
#endif
            GSYNC();
#ifndef SK_WO
            {
                PHASE_BEGIN
                pg8::Gemm g{WSP(bf16_t, WS_ACT), WSP(bf16_t, WS_WO) + (size_t)j * D * D, M, D, D, 256}; pg8::StaticOrder S; S.init(M, D, G, (int)blockIdx.x);
                EpiRes E{WSP(bf16_t, WS_HB), WSP(float, WS_PART)};
                pg8::gemm_phase<EpiRes, pg8::StaticOrder, true, true>(lds, g, S, E);
            }
#endif
            GSYNC();
        }
#ifndef SK_FI
        for (int rep_ = 0; rep_ < REP_FI; ++rep_) {
            PHASE_BEGIN
            const bf16_t* Wfi = (l < 2) ? WSP(const bf16_t, WS_WFI01) + (size_t)l * FF2 * D : WSP(const bf16_t, WS_WFI23) + (size_t)(l - 2) * FF2 * D;
            pg8::Gemm g{WSP(bf16_t, WS_HB), Wfi, M, FF2, D, 256}; pg8::StaticOrder S; S.init(M, FF2, G, (int)blockIdx.x);
            EpiConv E{ws, a.in[18] + (size_t)l * 3 * FF2, a.in[19] + (size_t)l * FF2, lds + XCH_OFF, l};
            pg8::gemm_phase<EpiConv, pg8::StaticOrder, true, true>(lds, g, S, E);
        }
#endif
        GSYNC();
#if REP_FOX
        {
            PHASE_BEGIN
            const bf16_t* Wfo = (l < 2) ? WSP(const bf16_t, WS_WFO01) + (size_t)l * D * FF : WSP(const bf16_t, WS_WFO23) + (size_t)(l - 2) * D * FF;
            pg8::Gemm g{WSP(bf16_t, WS_ACT), Wfo, M, D, FF, 256}; pg8::StaticOrder S; S.init(M, D, G, (int)blockIdx.x);
            EpiScale E{WSP(bf16_t, WS_BUFA), WSP(bf16_t, WS_BUFA), WSP(float, WS_PART), 1.0f};
            pg8::gemm_phase<EpiScale, pg8::StaticOrder, true, true>(lds, g, S, E);
        }
#endif
#ifndef SK_FO
        {
            PHASE_BEGIN
            const bf16_t* Wfo = (l < 2) ? WSP(const bf16_t, WS_WFO01) + (size_t)l * D * FF : WSP(const bf16_t, WS_WFO23) + (size_t)(l - 2) * D * FF;
            pg8::Gemm g{WSP(bf16_t, WS_ACT), Wfo, M, D, FF, 256}; pg8::StaticOrder S; S.init(M, D, G, (int)blockIdx.x);
            EpiRes E{WSP(bf16_t, WS_HB), WSP(float, WS_PART)};
            pg8::gemm_phase<EpiRes, pg8::StaticOrder, true, true>(lds, g, S, E);
        }
#endif
        GSYNC();
    }
    {
        PHASE_BEGIN
        int tid_l = threadIdx.x; asm volatile("" : "+v"(tid_l)); const int lane = tid_l & 63, wave = __builtin_amdgcn_readfirstlane(tid_l >> 6);
        const int gw = blockIdx.x * 8 + wave, NGW = G * 8; const float* part = WSP(float, WS_PART); float* hout = a.out;
        for (int m = gw; m < M; m += NGW) {
            const float rstd = rstd_row_wave(part, m, lane);
            __attribute__((address_space(1))) f32x4* xr = GASP(f32x4, hout + (size_t)m * D) + lane; const __attribute__((address_space(1))) f32x4* gf = GASP(const f32x4, a.in[21]) + lane; const __attribute__((address_space(1))) u32x2* hr = GASP(const u32x2, WSP(bf16_t, WS_HB) + (size_t)m * D) + lane;
#pragma unroll
            for (int j = 0; j < 4; ++j) { const u32x2 hw = hr[64 * j]; const f32x4 gg = gf[64 * j]; f32x4 v;
                v[0] = __builtin_bit_cast(float, hw.x << 16); v[1] = __builtin_bit_cast(float, hw.x & 0xffff0000u); v[2] = __builtin_bit_cast(float, hw.y << 16); v[3] = __builtin_bit_cast(float, hw.y & 0xffff0000u);
                v = v * rstd * gg; xr[64 * j] = v; }
        }
    }
}
}

extern "C" void kernel_launch(void* const* d_in, const int* in_sizes, int n_in, void* d_out, int out_size, void* d_ws, size_t ws_size, hipStream_t stream) {
    static int grid = 0;
    if (grid == 0) {
        if (n_in != 22 || out_size != yk::M * yk::D || ws_size < yk::WS_END) { fprintf(stderr, "kernel_launch: unexpected shapes (n_in %d out %d ws %zu)\n", n_in, out_size, ws_size); grid = -1; return; }
        int dev = 0, cus = 0, per_cu = 0;
        hipGetDevice(&dev); hipDeviceGetAttribute(&cus, hipDeviceAttributeMultiprocessorCount, dev);
        if (hipFuncSetAttribute((const void*)yk::yoco_fwd, hipFuncAttributeMaxDynamicSharedMemorySize, yk::LDS_BYTES) != hipSuccess) { fprintf(stderr, "hipFuncSetAttribute failed\n"); grid = -1; return; }
        if (hipOccupancyMaxActiveBlocksPerMultiprocessor(&per_cu, (const void*)yk::yoco_fwd, 512, yk::LDS_BYTES) != hipSuccess || per_cu < 1) { fprintf(stderr, "occupancy query: %d\n", per_cu); per_cu = 1; }
        (void)hipGetLastError();
        grid = cus * (per_cu > 1 ? 1 : per_cu);
    }
    if (grid < 0) return;
    yk::Args a{};
    for (int i = 0; i < 22; ++i) a.in[i] = (const float*)d_in[i];
    a.out = (float*)d_out; a.ws = (unsigned char*)d_ws;
    if (hipMemsetAsync(d_ws, 0, 65536, stream) != hipSuccess) { fprintf(stderr, "memset failed\n"); return; }
    void* args[] = {&a};
    hipError_t e = hipLaunchCooperativeKernel((const void*)yk::yoco_fwd, dim3(grid), dim3(512), args, yk::LDS_BYTES, stream);
    if (e != hipSuccess) fprintf(stderr, "cooperative launch failed: %s (grid %d)\n", hipGetErrorString(e), grid);
}
```
